# Optimizing an MI355X kernel written in HIP

```python
import jax, jax.numpy as jnp
from jax import lax
import numpy as np

D_MODEL = 2048
BATCH = 16
SEQ = 256
DEPTH = 2
DEC_BATCH = 4
DEC_SEQ = 1024
PAST_LEN = 256

GRID_W = 64
N_HEADS = 16
HEAD_DIM = 64
D_NA = N_HEADS * HEAD_DIM
D_F = D_MODEL // 2
N_FGROUPS = 4
F_GROUP = D_F // N_FGROUPS
KH_MAX = 8
KW = 16
Q_BLOCK_W = 16
K_BLOCK_W = KW + Q_BLOCK_W
D_FF = -(-8 * D_MODEL // (3 * 256)) * 256
D_IN = 3 * D_NA + D_F
EPS = 1e-6

kernel_name = "hybrid_natten_fnet_diffusion_step"


def rms_norm(x, g):
    xf = x.astype(jnp.float32)
    y = xf * lax.rsqrt(jnp.mean(xf * xf, axis=-1, keepdims=True) + EPS)
    return (y * g.astype(jnp.float32)).astype(x.dtype)


def modulation(cond, w_mod, b_mod):
    m = jax.nn.silu(cond) @ w_mod + b_mod
    return jnp.split(m[..., None, :], 6, axis=-1)


def project_in(h, w_in, q_g, k_g):
    p = h @ w_in
    q, k, v, u = jnp.split(p, [D_NA, 2 * D_NA, 3 * D_NA], axis=-1)
    shp = h.shape[:-1] + (N_HEADS, HEAD_DIM)
    q = rms_norm(q.reshape(shp), q_g)
    k = rms_norm(k.reshape(shp), k_g)
    return q, k, v.reshape(shp), u


def fourier_mix(u):
    b, t, _ = u.shape
    ug = u.reshape(b, t, N_FGROUPS, F_GROUP).astype(jnp.float32)
    f = jnp.fft.fft2(ug, axes=(1, 3), norm="ortho").real
    return f.reshape(b, t, D_F).astype(u.dtype)


def context_attention(q, k, v):
    s = jnp.einsum('bqhd,bkhd->bhqk', q, k).astype(jnp.float32) * (HEAD_DIM ** -0.5)
    p = jax.nn.softmax(s, axis=-1).astype(v.dtype)
    return jnp.einsum('bhqk,bkhd->bqhd', p, v)


def neighbourhood_attention(q, k, v, k_ctx, v_ctx, rpb):
    b, t, h, d = q.shape
    rows = t // GRID_W
    kh = min(KH_MAX, rows)
    nqb = GRID_W // Q_BLOCK_W
    r = jnp.arange(rows)
    row_idx = jnp.clip(r - kh // 2, 0, rows - kh)[:, None] + jnp.arange(kh)
    c0 = jnp.arange(nqb) * Q_BLOCK_W
    col_idx = jnp.clip(c0 - KW // 2, 0, GRID_W - K_BLOCK_W)[:, None] + jnp.arange(K_BLOCK_W)
    qc = c0[:, None] + jnp.arange(Q_BLOCK_W)
    win_start = jnp.clip(qc - KW // 2, 0, GRID_W - KW)[..., None]
    kc = col_idx[:, None, :]
    in_win = (kc >= win_start) & (kc < win_start + KW)
    dr = row_idx - r[:, None] + (KH_MAX - 1)
    dc = jnp.clip(kc - qc[..., None] + (KW - 1), 0, 2 * KW - 2)
    bias = rpb[:, dr[:, None, None, :, None], dc[None, :, :, None, :]].astype(jnp.float32)
    bias = jnp.where(in_win[None, None, :, :, None, :], bias, -jnp.inf)
    nk = kh * K_BLOCK_W
    bias = bias.reshape(h, rows, nqb, Q_BLOCK_W, nk)

    qg = q.reshape(b, rows, nqb, Q_BLOCK_W, h, d)
    kg = k.reshape(b, rows, GRID_W, h, d)
    vg = v.reshape(b, rows, GRID_W, h, d)
    ri = row_idx[:, None, :, None]
    ci = col_idx[None, :, None, :]
    kb = kg[:, ri, ci].reshape(b, rows, nqb, nk, h, d)
    vb = vg[:, ri, ci].reshape(b, rows, nqb, nk, h, d)

    scale = HEAD_DIM ** -0.5
    s_loc = jnp.einsum('brnqhd,brnkhd->bhrnqk', qg, kb).astype(jnp.float32) * scale + bias
    s_ctx = jnp.einsum('brnqhd,blhd->bhrnql', qg, k_ctx).astype(jnp.float32) * scale
    p = jax.nn.softmax(jnp.concatenate([s_loc, s_ctx], axis=-1), axis=-1).astype(v.dtype)
    o = (jnp.einsum('bhrnqk,brnkhd->brnqhd', p[..., :nk], vb)
         + jnp.einsum('bhrnql,blhd->brnqhd', p[..., nk:], v_ctx))
    return o.reshape(b, t, h, d)


def token_mixing(h, attn, u, w_na_proj, w_fnet_proj, w_gate, w_o):
    b, t = h.shape[:2]
    na = attn.reshape(b, t, D_NA) @ w_na_proj
    fn = fourier_mix(u) @ w_fnet_proj
    g_na, g_fn = jnp.split(jax.nn.sigmoid(h @ w_gate), 2, axis=-1)
    return (g_na * na + g_fn * fn) @ w_o


def swiglu(h, w_gate_up, w_down):
    a, g = jnp.split(h @ w_gate_up, 2, axis=-1)
    return (jax.nn.silu(g) * a) @ w_down


def trunk_layer(x, cond, lw, attend):
    (w_mod_l, b_mod_l, n1, n2, w_in_l, qg_l, kg_l,
     w_na_proj_l, w_fnet_proj_l, w_gate_l, w_o_l, w_gu_l, w_down_l) = lw
    sh1, sc1, g1, sh2, sc2, g2 = modulation(cond, w_mod_l, b_mod_l)
    h = rms_norm(x, n1) * (1 + sc1) + sh1
    q, k, v, u = project_in(h, w_in_l, qg_l, kg_l)
    attn = attend(q, k, v)
    x = x + g1 * token_mixing(h, attn, u, w_na_proj_l, w_fnet_proj_l, w_gate_l, w_o_l)
    h2 = rms_norm(x, n2) * (1 + sc2) + sh2
    x = x + g2 * swiglu(h2, w_gu_l, w_down_l)
    return x, k, v


def setup_inputs(seed: int = 0) -> dict:
    key = jax.random.key(seed)
    ks = jax.random.split(key, 24)
    nrm = lambda k, shape, s: jax.random.normal(k, shape, jnp.float32) * s
    return {
        "x_prompt": nrm(ks[0], (BATCH, SEQ, D_MODEL), 1.0),
        "x_sample": nrm(ks[1], (DEC_BATCH, DEC_SEQ, D_MODEL), 1.0),
        "cache_k": nrm(ks[2], (DEC_BATCH, DEPTH, PAST_LEN, N_HEADS, HEAD_DIM), 1.0),
        "cache_v": nrm(ks[3], (DEC_BATCH, DEPTH, PAST_LEN, N_HEADS, HEAD_DIM), 1.0),
        "c": nrm(ks[4], (DEC_BATCH, D_MODEL), 1.0),
        "c_ctx": nrm(ks[5], (D_MODEL,), 1.0),
        "w_mod": nrm(ks[6], (DEPTH, D_MODEL, 6 * D_MODEL), 0.5 * D_MODEL ** -0.5),
        "b_mod": nrm(ks[7], (DEPTH, 6 * D_MODEL), 0.02),
        "norm1_g": 1.0 + nrm(ks[8], (DEPTH, D_MODEL), 0.01),
        "norm2_g": 1.0 + nrm(ks[9], (DEPTH, D_MODEL), 0.01),
        "w_in": nrm(ks[10], (DEPTH, D_MODEL, D_IN), D_MODEL ** -0.5),
        "q_norm_g": 1.0 + nrm(ks[11], (DEPTH, HEAD_DIM), 0.01),
        "k_norm_g": 1.0 + nrm(ks[12], (DEPTH, HEAD_DIM), 0.01),
        "rpb": nrm(ks[13], (DEPTH, N_HEADS, 2 * KH_MAX - 1, 2 * KW - 1), 0.1),
        "w_na_proj": nrm(ks[14], (DEPTH, D_NA, D_MODEL), D_NA ** -0.5),
        "w_fnet_proj": nrm(ks[15], (DEPTH, D_F, D_MODEL), D_F ** -0.5),
        "w_gate": nrm(ks[16], (DEPTH, D_MODEL, 2 * D_MODEL), D_MODEL ** -0.5),
        "w_o": nrm(ks[17], (DEPTH, D_MODEL, D_MODEL), D_MODEL ** -0.5),
        "w_gate_up": nrm(ks[18], (DEPTH, D_MODEL, 2 * D_FF), D_MODEL ** -0.5),
        "w_down": nrm(ks[19], (DEPTH, D_FF, D_MODEL), D_FF ** -0.5),
    }


def reference(x_prompt, x_sample, cache_k, cache_v, c, c_ctx, w_mod, b_mod, norm1_g, norm2_g,
              w_in, q_norm_g, k_norm_g, rpb, w_na_proj, w_fnet_proj, w_gate, w_o, w_gate_up, w_down):
    y_prompt = x_prompt
    y_sample = x_sample
    new_ks = []
    new_vs = []
    for l in range(DEPTH):
        lw = (w_mod[l], b_mod[l], norm1_g[l], norm2_g[l], w_in[l], q_norm_g[l], k_norm_g[l],
              w_na_proj[l], w_fnet_proj[l], w_gate[l], w_o[l], w_gate_up[l], w_down[l])
        y_prompt, k_ctx, v_ctx = trunk_layer(y_prompt, c_ctx, lw, context_attention)
        new_ks.append(k_ctx)
        new_vs.append(v_ctx)
        ck = cache_k[:, l]
        cv = cache_v[:, l]
        rpb_l = rpb[l]
        attend_lat = lambda q, k, v, ck=ck, cv=cv, rpb_l=rpb_l: neighbourhood_attention(q, k, v, ck, cv, rpb_l)
        y_sample, _, _ = trunk_layer(y_sample, c, lw, attend_lat)
    new_k = jnp.stack(new_ks, axis=1)
    new_v = jnp.stack(new_vs, axis=1)
    return (y_prompt, y_sample, new_k, new_v)
```

```cpp
#include <hip/hip_runtime.h>
#include <cstdio>
#include <cstdint>


#ifndef MK_LAUNCH_PER_PHASE
#define MK_LAUNCH_PER_PHASE 0
#endif

#define LAS __attribute__((address_space(3)))
typedef unsigned short bf16_t;
typedef short bf16x8 __attribute__((ext_vector_type(8)));
typedef short s16x4 __attribute__((ext_vector_type(4)));
typedef float f32x4 __attribute__((ext_vector_type(4)));
typedef unsigned u32x4 __attribute__((ext_vector_type(4)));
typedef unsigned u32x2 __attribute__((ext_vector_type(2)));
typedef _Float16 h16x2 __attribute__((ext_vector_type(2)));
typedef short v4i16_t __attribute__((ext_vector_type(4)));

constexpr int DM = 2048, NTOK = 8192, NPR = 4096, DFF = 5632, NMOD = 12288;
constexpr float EPS = 1e-6f, LOG2E = 1.4426950408889634f;
constexpr size_t OUT_NEWK = 8192ull * 2048, OUT_NEWV = OUT_NEWK + 16ull * 2 * 256 * 1024;

constexpr size_t MiB = 1u << 20;
constexpr size_t WS_CTL = 0, CTL_BYTES = 128 * 1024;
constexpr size_t WS_MOD = 1 * MiB;
constexpr size_t WS_DCT = 2 * MiB;
constexpr size_t WS_DT256 = 3 * MiB;
constexpr size_t WS_DT1024 = 4 * MiB;
constexpr size_t WS_CK = 8 * MiB, WS_CV = 12 * MiB;
constexpr size_t WS_W = 16 * MiB, W_LAYER = 114 * MiB;
constexpr size_t WO_W1 = 0, WO_NA = 32 * MiB, WO_FN = 36 * MiB, WO_O = 40 * MiB, WO_GU = 48 * MiB, WO_D = 92 * MiB;
constexpr size_t WS_H = 244 * MiB;
constexpr size_t WS_Q = 276 * MiB, WS_K = 292 * MiB, WS_V = 308 * MiB;
constexpr size_t WS_UTS = 324 * MiB;
constexpr size_t WS_UTP = 332 * MiB;
constexpr size_t WS_G = 364 * MiB;
constexpr size_t WS_ATT = 428 * MiB;
constexpr size_t WS_Y = 444 * MiB;
constexpr size_t WS_F = 476 * MiB;
constexpr size_t WS_MIX = 492 * MiB;
constexpr size_t WS_X1 = 524 * MiB;
constexpr size_t WS_ACT = 364 * MiB;
constexpr size_t WS_X2 = 588 * MiB;
constexpr size_t WS_PART = 652 * MiB;
constexpr size_t WS_END = 653 * MiB;

constexpr int RING_BYTES = 131072, LDSCTL_OFF = 143360, LDS_BYTES = 145408;

#define LDS_WAIT() asm volatile("s_waitcnt lgkmcnt(0)" ::: "memory")
#define VM_WAIT() asm volatile("s_waitcnt vmcnt(0)" ::: "memory")
typedef float f32x2_t __attribute__((ext_vector_type(2)));
typedef __bf16 bf16x2_t __attribute__((ext_vector_type(2)));
__device__ __forceinline__ unsigned cvt_pk_bf16(float lo, float hi) { f32x2_t v = {lo, hi}; bf16x2_t b = __builtin_convertvector(v, bf16x2_t); return __builtin_bit_cast(unsigned, b); }
__device__ __forceinline__ unsigned pk_h16(float lo, float hi) { h16x2 h; h.x = (_Float16)lo; h.y = (_Float16)hi; return __builtin_bit_cast(unsigned, h); }
__device__ __forceinline__ float h16_lo(unsigned u) { h16x2 h = __builtin_bit_cast(h16x2, u); return (float)h.x; }
__device__ __forceinline__ float h16_hi(unsigned u) { h16x2 h = __builtin_bit_cast(h16x2, u); return (float)h.y; }
__device__ __forceinline__ float fexp2(float x) { return __builtin_amdgcn_exp2f(x); }
__device__ __forceinline__ float frcp(float x) { return __builtin_amdgcn_rcpf(x); }
__device__ __forceinline__ float sigmoidf_(float x) { return frcp(1.0f + fexp2(-x * LOG2E)); }
#define GAS __attribute__((address_space(1)))
__device__ __forceinline__ f32x4 ldg_f4(const void* p) { return *(const GAS f32x4*)p; }
__device__ __forceinline__ u32x4 ldg_u4(const void* p) { return *(const GAS u32x4*)p; }
__device__ __forceinline__ void stg_f4(void* p, f32x4 v) { *(GAS f32x4*)p = v; }
__device__ __forceinline__ void stg_u4(void* p, u32x4 v) { *(GAS u32x4*)p = v; }
__device__ __forceinline__ void stg_u2(void* p, u32x2 v) { *(GAS u32x2*)p = v; }
__device__ __forceinline__ int iclamp(int v, int lo, int hi) { return v < lo ? lo : (v > hi ? hi : v); }
__device__ __forceinline__ int rho256(int L) { return 128 * ((L >> 5) & 1) + 32 * (L >> 6) + 16 * ((L >> 2) & 1) + 4 * ((L >> 3) & 3) + (L & 3); }
__device__ __forceinline__ int rho256_inv(int r) { const int bj = r >> 7, wc = (r >> 5) & 3, n = (r >> 4) & 1, fq = (r >> 2) & 3, j = r & 3; return 64 * wc + 32 * bj + 8 * fq + 4 * n + j; }

#define XB_TMO      128
#define XB_XCNT(j)  (256  + 64 * (j))
#define XB_XSUB(j)  (1280 + 64 * (j))
#define XB_XGEN(j)  (2304 + 64 * (j))
#define XB_TOP      3328
#define XB_TOPGEN   3392
#define XCD_BAR_WORDS 3456
#define XB_SPIN_CAP (1u << 20)
__device__ __forceinline__ unsigned xb_ld(unsigned* p)              { return __hip_atomic_load(p, __ATOMIC_RELAXED, __HIP_MEMORY_SCOPE_AGENT); }
__device__ __forceinline__ unsigned xb_add(unsigned* p, unsigned v) { return __hip_atomic_fetch_add(p, v, __ATOMIC_RELAXED, __HIP_MEMORY_SCOPE_AGENT); }
__device__ __forceinline__ unsigned xb_xcc_id() { return (unsigned)__builtin_amdgcn_s_getreg((3 << 11) | 20) & 0xFu; }
#define XB_SPIN(cond, bar) do { unsigned _sp = 0; while (cond) { __builtin_amdgcn_s_sleep(1); \
    if ((++_sp & 255u) == 0u) { if (xb_ld(&(bar)[XB_TMO])) break; if (_sp > XB_SPIN_CAP) { atomicAdd(&(bar)[XB_TMO], 1u); break; } } } } while (0)
struct XcdBarrier { unsigned* bar; unsigned x; volatile LAS unsigned* st; };
__device__ __forceinline__ XcdBarrier xcd_barrier_post(unsigned* bar, volatile LAS unsigned* st) {
    XcdBarrier b; b.bar = bar; b.x = xb_xcc_id(); b.st = st;
    if (threadIdx.x == 0) (void)xb_add(&bar[XB_XCNT(b.x)], 1u);
    return b;
}
__device__ __forceinline__ void xcd_barrier_complete(unsigned* bar, unsigned x, unsigned& nloc, unsigned& nx) {
    const unsigned G = gridDim.x * gridDim.y * gridDim.z;
    unsigned sum, cnt, mine, sp = 0u;
    for (;;) {
        sum = 0u; cnt = 0u; mine = 0u;
#pragma unroll
        for (unsigned j = 0; j < 16; ++j) { const unsigned c = xb_ld(&bar[XB_XCNT(j)]); sum += c; cnt += (c > 0u) ? 1u : 0u; mine = (j == x) ? c : mine; }
        if (sum == G) break;
        __builtin_amdgcn_s_sleep(1);
        if ((++sp & 255u) == 0u) { if (xb_ld(&bar[XB_TMO])) break; if (sp > XB_SPIN_CAP) { atomicAdd(&bar[XB_TMO], 1u); break; } }
    }
    nloc = mine > 0u ? mine : 1u; nx = cnt > 0u ? cnt : 1u;
}
__device__ __forceinline__ void xcd_barrier(const XcdBarrier& b) {
    asm volatile("s_waitcnt vmcnt(0)" ::: "memory");
    __syncthreads();
    if (threadIdx.x == 0) {
        unsigned* bar = b.bar;
        __builtin_amdgcn_s_waitcnt(0);
        unsigned nloc = b.st[0], nx = b.st[1];
        if (nloc == 0u) { xcd_barrier_complete(bar, b.x, nloc, nx); b.st[0] = nloc; b.st[1] = nx; }
        const unsigned old = xb_add(&bar[XB_XSUB(b.x)], 1u);
        const unsigned gen = old / nloc;
        if (old + 1u == (gen + 1u) * nloc) {
            __builtin_amdgcn_fence(__ATOMIC_RELEASE, "agent");
            asm volatile("s_waitcnt vmcnt(0)" ::: "memory");
            const unsigned og = xb_add(&bar[XB_TOP], 1u);
            const unsigned tg = og / nx;
            if (og + 1u == (tg + 1u) * nx) xb_add(&bar[XB_TOPGEN], 1u);
            else XB_SPIN(xb_ld(&bar[XB_TOPGEN]) == tg, bar);
            __builtin_amdgcn_fence(__ATOMIC_ACQUIRE, "agent");
            xb_add(&bar[XB_XGEN(b.x)], 1u);
            asm volatile("s_waitcnt vmcnt(0)" ::: "memory");
        } else {
            XB_SPIN(xb_ld(&bar[XB_XGEN(b.x)]) == gen, bar);
            __builtin_amdgcn_fence(__ATOMIC_ACQUIRE, "agent");
            asm volatile("s_waitcnt vmcnt(0)" ::: "memory");
        }
    }
    __syncthreads();
}

struct Args { const float* in[20]; float* out; unsigned char* ws; int ph_lo, ph_hi; };
typedef __attribute__((address_space(4))) const Args CArgs;
struct Frame {
    LAS unsigned char* lds;
    int wave, G, bid;
    float* out; unsigned char* ws;
};
#define FIN(i) (((CArgs*)__builtin_amdgcn_kernarg_segment_ptr())->in[i])
__device__ __forceinline__ int lane_id_volatile() { int l_; asm volatile("v_mbcnt_lo_u32_b32 %0, -1, 0\n\tv_mbcnt_hi_u32_b32 %0, -1, %0" : "=v"(l_)); return l_; }
#define FTID(F) ((F).wave * 64 + lane_id_volatile())
#define IN_XP 0
#define IN_XS 1
#define IN_CK 2
#define IN_CV 3
#define IN_C 4
#define IN_CCTX 5
#define IN_WMOD 6
#define IN_BMOD 7
#define IN_N1 8
#define IN_N2 9
#define IN_WIN 10
#define IN_QG 11
#define IN_KG 12
#define IN_RPB 13
#define IN_WNA 14
#define IN_WFN 15
#define IN_WGATE 16
#define IN_WO 17
#define IN_WGU 18
#define IN_WD 19

__device__ __forceinline__ int cond_of_pm(int pm) { return pm < 16 ? 4 : ((pm - 16) >> 2); }

constexpr int BM = 256, BK = 64, HALF = 128, HTB = HALF * BK * 2, NXCD = 8, WGM = 8;
__device__ __forceinline__ int lds_byte(int r, int c) { const int st = (r >> 4) * 2 + (c >> 5), rr = r & 15, cc = c & 31, ob = rr * 64 + cc * 2; return st * 1024 + (ob ^ (((ob >> 9) & 1) << 5)); }
__device__ __forceinline__ void stage_rc(int b, int& R, int& C) { const int st = b / 1024, sb = b % 1024, swz = sb ^ (((sb >> 9) & 1) << 5); R = (st >> 1) * 16 + swz / 64; C = (st & 1) * 32 + (swz % 64) / 2; }

#ifndef MK_SP2
#define MK_SP2 true
#endif
#ifndef MK_ALIGN
#define MK_ALIGN true
#endif
constexpr bool GEMM_SP2 = MK_SP2, GEMM_ALIGN_EPI = MK_ALIGN;
enum GemmType { GT_G1 = 0, GT_DFTPOS = 1, GT_DFTCH = 2, GT_G2 = 3, GT_G3 = 4, GT_G4 = 5, GT_G5 = 6, GT_G4M = 7 };
enum EpiKind { K_Q = 0, K_K, K_V, K_UT, K_G, K_Y, K_F, K_MIXA, K_MIXB, K_X1, K_ACT, K_X2 };
typedef const GAS char* gcptr;
struct Unit { gcptr A; gcptr B; int nt, kind, pm, pn, orow, ocol; };

__device__ __forceinline__ void tile_order(int L, int nM, int nN, int& pm, int& pn) {
    const int nwg = nM * nN; int wgid = L;
    { const int q = nwg / NXCD, r = nwg % NXCD, xcd = wgid % NXCD, off = wgid / NXCD; wgid = (xcd < r ? xcd * (q + 1) : r * (q + 1) + (xcd - r) * q) + off; }
    const int nig = WGM * nN, gid = wgid / nig, fm = gid * WGM, gsz = (nM - fm) < WGM ? (nM - fm) : WGM;
    pm = fm + ((wgid % nig) % gsz); pn = (wgid % nig) / gsz;
}

__device__ __forceinline__ bool get_unit(const Frame& F, int gt, int l, int i, int Geff, Unit& u) {
    size_t wso = 0; asm volatile("" : "+s"(wso));
    gcptr ws = (gcptr)F.ws + wso; const int G = Geff, c = F.bid;
    gcptr wl = ws + WS_W + (size_t)l * W_LAYER;
    u.orow = 0; u.ocol = 0;
    switch (gt) {
    case GT_G1: {
        const int L = i * G + c; if (L >= 32 * 32) return false;
        int pm, pn; tile_order(L, 32, 32, pm, pn); u.pm = pm; u.pn = pn; u.nt = 32;
        gcptr hrow = ws + WS_H + (size_t)pm * 256 * DM * 2; gcptr wrow = wl + WO_W1 + (size_t)pn * 256 * DM * 2;
        if (pn >= 12 && pn < 16) { u.A = wrow; u.B = hrow; u.kind = K_UT; u.ocol = (pn - 12) * 256; }
        else { u.A = hrow; u.B = wrow; u.kind = pn < 4 ? K_Q : (pn < 8 ? K_K : (pn < 12 ? K_V : K_G)); u.ocol = (pn < 4 ? pn : (pn < 8 ? pn - 4 : (pn < 12 ? pn - 8 : pn - 16))) * 256; }
        return true; }
    case GT_DFTPOS: {
        const int p = c + (i / 3) * G, sub = i % 3; if (p >= 128) return false;
        int b, mt, g, pm, T4;
        if (p < 64) { b = p >> 4; mt = (p >> 2) & 3; g = p & 3; pm = 16 + b * 4 + mt; T4 = 16; } else { b = (p - 64) >> 2; mt = 0; g = p & 3; pm = b; T4 = 4; }
        u.pm = pm; u.pn = g;
        if (sub < 2) { u.kind = K_Y; u.nt = T4; u.ocol = sub; u.orow = pm * 256;
            u.A = (p < 64) ? ws + WS_DT1024 + (size_t)(sub * 1024 + mt * 256) * 1024 * 2 : ws + WS_DT256 + (size_t)(sub * 256) * 1024 * 2;
            u.B = (p < 64) ? ws + WS_UTS + (size_t)(b * 1024 + g * 256) * 1024 * 2 : ws + WS_UTP + (size_t)(b * 1024 + g * 256) * 1024 * 2; }
        else { u.kind = K_F; u.nt = 8; u.orow = pm * 256; u.ocol = g * 256;
            u.A = ws + WS_Y + (((size_t)(g >> 1) * NTOK + pm * 256) * 1024 + (g & 1) * 512) * 2; u.B = ws + WS_DCT; }
        return true; }
    case GT_G2: {
        const int L = (i >> 1) * G + c; if (L >= 256) return false;
        int pm, pn; tile_order(L, 32, 8, pm, pn); u.pm = pm; u.pn = pn; u.nt = 16;
        if ((i & 1) == 0) { u.A = ws + WS_ATT + (size_t)pm * 256 * 1024 * 2; u.B = wl + WO_NA + (size_t)pn * 256 * 1024 * 2; u.kind = K_MIXA; }
        else { u.A = ws + WS_F + (size_t)pm * 256 * 1024 * 2; u.B = wl + WO_FN + (size_t)pn * 256 * 1024 * 2; u.kind = K_MIXB; }
        return true; }
    case GT_G3: {
        const int L = i * G + c; if (L >= 256) return false;
        int pm, pn; tile_order(L, 32, 8, pm, pn); u.pm = pm; u.pn = pn; u.nt = 32; u.kind = K_X1;
        u.A = ws + WS_MIX + (size_t)pm * 256 * DM * 2; u.B = wl + WO_O + (size_t)pn * 256 * DM * 2;
        return true; }
    case GT_G4: case GT_G4M: {
        const int L = i * G + c; if (L >= 32 * 44 || (gt == GT_G4M && i >= 5)) return false;
        int pm, pn; tile_order(L, 32, 44, pm, pn); u.pm = pm; u.pn = pn; u.nt = 32; u.kind = K_ACT;
        u.A = ws + WS_H + (size_t)pm * 256 * DM * 2; u.B = wl + WO_GU + (size_t)pn * 256 * DM * 2;
        return true; }
    default: {
        const int L = i * G + c; if (L >= 256) return false;
        int pm, pn; tile_order(L, 32, 8, pm, pn); u.pm = pm; u.pn = pn; u.nt = 88; u.kind = K_X2;
        u.A = ws + WS_ACT + (size_t)pm * 256 * DFF * 2; u.B = wl + WO_D + (size_t)pn * 256 * DFF * 2;
        return true; }
    }
}

__device__ __forceinline__ void epilogue(const f32x4 (&acc)[2][2][4][2], const Unit& u, const Frame& F, int l, int wr, int wc, int fr, int fq) {
    size_t wso = 0; asm volatile("" : "+s"(wso));
    unsigned char* ws = F.ws + wso;
    int rt0 = wr * 64 + fr;
    int c8 = wc * 64 + fq * 8;
    asm volatile("" : "+v"(rt0), "+v"(c8));
    switch (u.kind) {
    case K_Q: case K_K: {
        const bool isq = (u.kind == K_Q);
        const float* gam = (isq ? FIN(IN_QG) : FIN(IN_KG)) + l * 64; const float gs = isq ? 0.125f : 1.0f;
        f32x4 gv[2][2];
#pragma unroll
        for (int bj = 0; bj < 2; ++bj)
#pragma unroll
            for (int n = 0; n < 2; ++n) gv[bj][n] = ldg_f4(gam + 32 * bj + 8 * fq + 4 * n) * gs;
        bf16_t* dst = (bf16_t*)(ws + (isq ? WS_Q : WS_K)) + (size_t)(u.pm * 256 + rt0) * 1024 + u.ocol + c8;
        float* dk = F.out + OUT_NEWK + ((size_t)(u.pm * 2 + l) * 256 + rt0) * 1024 + u.ocol + c8;
        const bool wk = (!isq) && (u.pm < 16);
#pragma unroll
        for (int ai = 0; ai < 2; ++ai)
#pragma unroll
            for (int m = 0; m < 4; ++m) {
                float ss = 0.f;
#pragma unroll
                for (int bj = 0; bj < 2; ++bj)
#pragma unroll
                    for (int n = 0; n < 2; ++n) { const f32x4 v = acc[ai][bj][m][n]; ss += (v[0] * v[0] + v[1] * v[1]) + (v[2] * v[2] + v[3] * v[3]); }
                ss += __shfl_xor(ss, 16); ss += __shfl_xor(ss, 32);
                const float rs = __builtin_amdgcn_rsqf(ss * (1.0f / 64.0f) + EPS);
                const size_t ro = (size_t)(ai * 128 + m * 16) * 1024;
#pragma unroll
                for (int bj = 0; bj < 2; ++bj) {
                    const f32x4 o0 = acc[ai][bj][m][0] * rs * gv[bj][0], o1 = acc[ai][bj][m][1] * rs * gv[bj][1];
                    u32x4 w; w.x = cvt_pk_bf16(o0[0], o0[1]); w.y = cvt_pk_bf16(o0[2], o0[3]); w.z = cvt_pk_bf16(o1[0], o1[1]); w.w = cvt_pk_bf16(o1[2], o1[3]);
                    stg_u4(dst + ro + 32 * bj, w);
                    if (wk) { stg_f4(dk + ro + 32 * bj, o0); stg_f4(dk + ro + 32 * bj + 4, o1); }
                }
            }
        break; }
    case K_V: {
        bf16_t* dst = (bf16_t*)(ws + WS_V) + (size_t)(u.pm * 256 + rt0) * 1024 + u.ocol + c8;
        float* dv = F.out + OUT_NEWV + ((size_t)(u.pm * 2 + l) * 256 + rt0) * 1024 + u.ocol + c8;
        const bool wv = (u.pm < 16);
#pragma unroll
        for (int ai = 0; ai < 2; ++ai)
#pragma unroll
            for (int m = 0; m < 4; ++m) { const size_t ro = (size_t)(ai * 128 + m * 16) * 1024;
#pragma unroll
                for (int bj = 0; bj < 2; ++bj) { const f32x4 o0 = acc[ai][bj][m][0], o1 = acc[ai][bj][m][1];
                    u32x4 w; w.x = cvt_pk_bf16(o0[0], o0[1]); w.y = cvt_pk_bf16(o0[2], o0[3]); w.z = cvt_pk_bf16(o1[0], o1[1]); w.w = cvt_pk_bf16(o1[2], o1[3]);
                    stg_u4(dst + ro + 32 * bj, w);
                    if (wv) { stg_f4(dv + ro + 32 * bj, o0); stg_f4(dv + ro + 32 * bj + 4, o1); } } }
        break; }
    case K_UT: {
        const int pm = u.pm; bf16_t* base;
        if (pm >= 16) base = (bf16_t*)(ws + WS_UTS) + ((size_t)((pm - 16) >> 2) * 1024 + u.ocol) * 1024 + ((pm - 16) & 3) * 256;
        else base = (bf16_t*)(ws + WS_UTP) + ((size_t)pm * 1024 + u.ocol) * 1024;
        base += (size_t)rt0 * 1024 + wc * 32 + fq * 4;
#pragma unroll
        for (int ai = 0; ai < 2; ++ai)
#pragma unroll
            for (int m = 0; m < 4; ++m) { bf16_t* rp = base + (size_t)(ai * 128 + m * 16) * 1024;
#pragma unroll
                for (int bj = 0; bj < 2; ++bj)
#pragma unroll
                    for (int n = 0; n < 2; ++n) { const f32x4 v = acc[ai][bj][m][n]; u32x2 w; w.x = cvt_pk_bf16(v[0], v[1]); w.y = cvt_pk_bf16(v[2], v[3]); stg_u2(rp + 128 * bj + 16 * n, w); } }
        break; }
    case K_G: {
        unsigned short* dst = (unsigned short*)(ws + WS_G) + (size_t)(u.pm * 256 + rt0) * 4096 + u.ocol + c8;
#pragma unroll
        for (int ai = 0; ai < 2; ++ai)
#pragma unroll
            for (int m = 0; m < 4; ++m) { const size_t ro = (size_t)(ai * 128 + m * 16) * 4096;
#pragma unroll
                for (int bj = 0; bj < 2; ++bj) { const f32x4 o0 = acc[ai][bj][m][0], o1 = acc[ai][bj][m][1];
                    u32x4 w; w.x = pk_h16(sigmoidf_(o0[0]), sigmoidf_(o0[1])); w.y = pk_h16(sigmoidf_(o0[2]), sigmoidf_(o0[3])); w.z = pk_h16(sigmoidf_(o1[0]), sigmoidf_(o1[1])); w.w = pk_h16(sigmoidf_(o1[2]), sigmoidf_(o1[3]));
                    stg_u4(dst + ro + 32 * bj, w); } }
        break; }
    case K_Y: case K_F: {
        const bool isy = (u.kind == K_Y);
        bf16_t* dst = isy ? (bf16_t*)(ws + WS_Y) + ((size_t)(u.pn >> 1) * NTOK + u.orow + rt0) * 1024 + (u.pn & 1) * 512 + u.ocol * 256 + c8
                          : (bf16_t*)(ws + WS_F) + (size_t)(u.orow + rt0) * 1024 + u.ocol + c8;
#pragma unroll
        for (int ai = 0; ai < 2; ++ai)
#pragma unroll
            for (int m = 0; m < 4; ++m) { const size_t ro = (size_t)(ai * 128 + m * 16) * 1024;
#pragma unroll
                for (int bj = 0; bj < 2; ++bj) { const f32x4 o0 = acc[ai][bj][m][0], o1 = acc[ai][bj][m][1];
                    u32x4 w; w.x = cvt_pk_bf16(o0[0], o0[1]); w.y = cvt_pk_bf16(o0[2], o0[3]); w.z = cvt_pk_bf16(o1[0], o1[1]); w.w = cvt_pk_bf16(o1[2], o1[3]);
                    stg_u4(dst + ro + 32 * bj, w); } }
        if (isy) asm volatile("s_waitcnt vmcnt(0)" ::: "memory");
        break; }
    case K_MIXA: case K_MIXB: {
        const unsigned short* gb = (const unsigned short*)(ws + WS_G) + (size_t)(u.pm * 256 + rt0) * 4096 + u.pn * 256 + c8 + 2048;
        bf16_t* dst = (bf16_t*)(ws + WS_MIX) + (size_t)(u.pm * 256 + rt0) * DM + u.pn * 256 + c8;
        u32x4 gg[2][2];
#define MIXB_LOAD(slot, g) do { const size_t rg_ = (size_t)(((g) >> 2) * 128 + ((g) & 3) * 16) * 4096; _Pragma("unroll") for (int bj = 0; bj < 2; ++bj) gg[slot][bj] = ldg_u4(gb + rg_ + 32 * bj); } while (0)
        MIXB_LOAD(0, 0);
#pragma unroll
        for (int g = 0; g < 8; ++g) { const int ai = g >> 2, m = g & 3, sl = g & 1; const size_t ro = (size_t)(ai * 128 + m * 16) * DM;
            if (g < 7) MIXB_LOAD((g + 1) & 1, g + 1);
#pragma unroll
            for (int bj = 0; bj < 2; ++bj) {
                const u32x4 q = gg[sl][bj];
                const f32x4 g0 = (f32x4){fmaxf(h16_lo(q.x), 1e-30f), fmaxf(h16_hi(q.x), 1e-30f), fmaxf(h16_lo(q.y), 1e-30f), fmaxf(h16_hi(q.y), 1e-30f)}, g1 = (f32x4){fmaxf(h16_lo(q.z), 1e-30f), fmaxf(h16_hi(q.z), 1e-30f), fmaxf(h16_lo(q.w), 1e-30f), fmaxf(h16_hi(q.w), 1e-30f)};
                const f32x4 o0 = acc[ai][bj][m][0] * g0, o1 = acc[ai][bj][m][1] * g1;
                u32x4 w; w.x = cvt_pk_bf16(o0[0], o0[1]); w.y = cvt_pk_bf16(o0[2], o0[3]); w.z = cvt_pk_bf16(o1[0], o1[1]); w.w = cvt_pk_bf16(o1[2], o1[3]);
                stg_u4(dst + ro + 32 * bj, w); } }
#undef MIXB_LOAD
        break; }
    case K_X1: case K_X2: {
        const bool is1 = (u.kind == K_X1);
        const int cond = cond_of_pm(u.pm);
        const float* gate = (const float*)(ws + WS_MOD) + (size_t)(l * 5 + cond) * NMOD + (is1 ? 2 : 5) * DM + u.pn * 256 + c8;
        f32x4 gv[2][2];
#pragma unroll
        for (int bj = 0; bj < 2; ++bj)
#pragma unroll
            for (int n = 0; n < 2; ++n) gv[bj][n] = ldg_f4(gate + 32 * bj + 4 * n);
        const size_t eo = (size_t)(u.pm * 256 + rt0) * DM + u.pn * 256 + c8;
        const float* src; float* dst;
        if (is1) { src = (l == 0) ? (u.pm < 16 ? FIN(IN_XP) : FIN(IN_XS) - (size_t)NPR * DM) : (const float*)(ws + WS_X2); dst = (float*)(ws + WS_X1); }
        else { src = (const float*)(ws + WS_X1); dst = (l == 0) ? (float*)(ws + WS_X2) : F.out; }
        src += eo; dst += eo;
        f32x4 xr[2][4];
#define XRES_LOAD(slot, g) do { const size_t ro_ = (size_t)(((g) >> 2) * 128 + ((g) & 3) * 16) * DM; \
            _Pragma("unroll") for (int bj = 0; bj < 2; ++bj) { xr[slot][2 * bj] = ldg_f4(src + ro_ + 32 * bj); xr[slot][2 * bj + 1] = ldg_f4(src + ro_ + 32 * bj + 4); } } while (0)
        XRES_LOAD(0, 0);
#pragma unroll
        for (int g = 0; g < 8; ++g) { const int ai = g >> 2, m = g & 3, sl = g & 1; const size_t ro = (size_t)(ai * 128 + m * 16) * DM;
            if (g < 7) XRES_LOAD((g + 1) & 1, g + 1);
#pragma unroll
            for (int bj = 0; bj < 2; ++bj)
#pragma unroll
                for (int n = 0; n < 2; ++n) stg_f4(dst + ro + 32 * bj + 4 * n, xr[sl][2 * bj + n] + gv[bj][n] * acc[ai][bj][m][n]); }
#undef XRES_LOAD
        break; }
    default: {
        bf16_t* dst = (bf16_t*)(ws + WS_ACT) + (size_t)(u.pm * 256 + rt0) * DFF + u.pn * 128 + wc * 32 + fq * 8;
#pragma unroll
        for (int ai = 0; ai < 2; ++ai)
#pragma unroll
            for (int m = 0; m < 4; ++m) { float o[8];
#pragma unroll
                for (int e = 0; e < 8; ++e) { const float a = acc[ai][0][m][e >> 2][e & 3], g = acc[ai][1][m][e >> 2][e & 3]; o[e] = a * g * sigmoidf_(g); }
                u32x4 w; w.x = cvt_pk_bf16(o[0], o[1]); w.y = cvt_pk_bf16(o[2], o[3]); w.z = cvt_pk_bf16(o[4], o[5]); w.w = cvt_pk_bf16(o[6], o[7]);
                stg_u4(dst + (size_t)(ai * 128 + m * 16) * DFF, w); }
        break; }
    }
}


__device__ __forceinline__ void mixa_scale(f32x4 (&acc)[2][2][4][2], const Unit& u, const Frame& F, int wr, int wc, int fr, int fq) {
    size_t wso = 0; asm volatile("" : "+s"(wso)); unsigned char* ws = F.ws + wso;
    int rt0 = wr * 64 + fr, c8 = wc * 64 + fq * 8; asm volatile("" : "+v"(rt0), "+v"(c8));
    const unsigned short* gb = (const unsigned short*)(ws + WS_G) + (size_t)(u.pm * 256 + rt0) * 4096 + u.pn * 256 + c8;
#pragma unroll
    for (int g = 0; g < 8; ++g) { const int ai = g >> 2, m = g & 3; const size_t rg = (size_t)(ai * 128 + m * 16) * 4096;
#pragma unroll
        for (int bj = 0; bj < 2; ++bj) { const u32x4 a = ldg_u4(gb + rg + 32 * bj), f = ldg_u4(gb + rg + 2048 + 32 * bj);
            const float an[8] = {h16_lo(a.x), h16_hi(a.x), h16_lo(a.y), h16_hi(a.y), h16_lo(a.z), h16_hi(a.z), h16_lo(a.w), h16_hi(a.w)};
            const float fn_[8] = {h16_lo(f.x), h16_hi(f.x), h16_lo(f.y), h16_hi(f.y), h16_lo(f.z), h16_hi(f.z), h16_lo(f.w), h16_hi(f.w)};
#pragma unroll
            for (int e = 0; e < 8; ++e) acc[ai][bj][m][e >> 2][e & 3] *= an[e] * frcp(fmaxf(fn_[e], 1e-30f)); } }
}

__device__ __forceinline__ void fused_resnorm_epilogue(f32x4 (&acc)[2][2][4][2], const Unit& u, const Frame& F, int l, bool is1) {
    unsigned char* ws = F.ws;
    int tid = FTID(F); asm volatile("" : "+v"(tid));
    const int lane = tid & 63, fr = lane & 15, fq = lane >> 4, wr = F.wave >> 2, wc = F.wave & 3;
    const int rt0 = wr * 64 + fr, c8 = wc * 64 + fq * 8, cond = cond_of_pm(u.pm), use = is1 ? 2 * l : 2 * l + 1;
    const size_t tile_el = (size_t)u.pm * 256 * DM + u.pn * 256;
    const unsigned lo4 = (unsigned)(rt0 * DM + c8) * 4u, lo2 = (unsigned)(rt0 * DM + c8) * 2u;
    const char* srcb; char* dstb;
    if (is1) { srcb = (const char*)((l == 0) ? (u.pm < 16 ? FIN(IN_XP) : FIN(IN_XS) - (size_t)NPR * DM) : (const float*)(ws + WS_X2)); dstb = (char*)(ws + WS_X1); }
    else { srcb = (const char*)(ws + WS_X1); dstb = (char*)(ws + WS_X2); }
    srcb += tile_el * 4; dstb += tile_el * 4;
    const float* gate = (const float*)(ws + WS_MOD) + (size_t)(l * 5 + cond) * NMOD + (is1 ? 2 : 5) * DM + u.pn * 256 + c8;
#define GRP_OFF(g, elsz) ((size_t)((((g) >> 2) * 128 + ((g) & 3) * 16) * DM) * (elsz))
    float ssq[8];
#pragma unroll
    for (int g = 0; g < 8; ++g) ssq[g] = 0.f;
#pragma unroll
    for (int bj = 0; bj < 2; ++bj) {
        f32x4 xr[2][2], gv[2];
        gv[0] = ldg_f4(gate + 32 * bj); gv[1] = ldg_f4(gate + 32 * bj + 4);
        xr[0][0] = ldg_f4(srcb + (lo4 + 128u * bj)); xr[0][1] = ldg_f4(srcb + (lo4 + 128u * bj + 16u));
#pragma unroll
        for (int g = 0; g < 8; ++g) { const int ai = g >> 2, m = g & 3, sl = g & 1;
            if (g < 7) { xr[sl ^ 1][0] = ldg_f4(srcb + GRP_OFF(g + 1, 4) + (lo4 + 128u * bj)); xr[sl ^ 1][1] = ldg_f4(srcb + GRP_OFF(g + 1, 4) + (lo4 + 128u * bj + 16u)); }
#pragma unroll
            for (int n = 0; n < 2; ++n) { const f32x4 xn = xr[sl][n] + gv[n] * acc[ai][bj][m][n]; stg_f4(dstb + GRP_OFF(g, 4) + (lo4 + 128u * bj + 16u * n), xn); acc[ai][bj][m][n] = xn;
                ssq[g] += (xn[0] * xn[0] + xn[1] * xn[1]) + (xn[2] * xn[2] + xn[3] * xn[3]); }
            asm volatile("" ::: "memory"); }
    }
    { float* part = (float*)(ws + WS_PART) + ((size_t)u.pm * 256 + rt0) * 32 + u.pn * 4 + wc;
#pragma unroll
      for (int g = 0; g < 8; ++g) { float ss = ssq[g]; ss += __shfl_xor(ss, 16); ss += __shfl_xor(ss, 32);
          __hip_atomic_store(part + (size_t)((g >> 2) * 128 + (g & 3) * 16) * 32, ss, __ATOMIC_RELAXED, __HIP_MEMORY_SCOPE_AGENT); } }
    asm volatile("s_waitcnt vmcnt(0)" ::: "memory");
    unsigned* cnt = (unsigned*)(ws + WS_CTL + 65536) + (size_t)(use * 32 + u.pm) * 64;
    if (lane == 0) __hip_atomic_fetch_add(cnt, 1u, __ATOMIC_RELAXED, __HIP_MEMORY_SCOPE_AGENT);
    if (F.wave == 0) { unsigned sp = 0u;
        while ((unsigned)__builtin_amdgcn_readfirstlane(__hip_atomic_load(cnt, __ATOMIC_RELAXED, __HIP_MEMORY_SCOPE_AGENT)) < 64u) { __builtin_amdgcn_s_sleep(2); if (++sp > (1u << 19)) break; }
        __builtin_amdgcn_fence(__ATOMIC_ACQUIRE, "agent");
        asm volatile("s_waitcnt vmcnt(0)" ::: "memory"); }
    asm volatile("s_waitcnt vmcnt(0) lgkmcnt(0)" ::: "memory"); __builtin_amdgcn_s_barrier(); asm volatile("" ::: "memory");
    LAS float* S = (LAS float*)(F.lds);
    { const int row = F.wave * 32 + (lane & 31), half = lane >> 5; const float* pr = (const float*)(ws + WS_PART) + ((size_t)u.pm * 256 + row) * 32 + half * 16;
      float t = 0.f;
#pragma unroll
      for (int k = 0; k < 8; ++k) { const unsigned long long v2 = __hip_atomic_load((const unsigned long long*)pr + k, __ATOMIC_RELAXED, __HIP_MEMORY_SCOPE_AGENT);
          t += __uint_as_float((unsigned)v2) + __uint_as_float((unsigned)(v2 >> 32)); }
      t += __shfl_xor(t, 32);
      if (half == 0) S[row] = __builtin_amdgcn_rsqf(t * (1.0f / DM) + EPS); }
    asm volatile("s_waitcnt lgkmcnt(0)" ::: "memory"); __builtin_amdgcn_s_barrier(); asm volatile("" ::: "memory");
    const int ln = is1 ? l : l + 1;
    const float* gam = (is1 ? FIN(IN_N2) : FIN(IN_N1)) + ln * DM + u.pn * 256 + c8;
    const float* modp = (const float*)(ws + WS_MOD) + (size_t)(ln * 5 + cond) * NMOD + (is1 ? 3 : 0) * DM + u.pn * 256 + c8;
    char* hdb = (char*)(ws + WS_H) + tile_el * 2;
    float rs8[8];
#pragma unroll
    for (int g = 0; g < 8; ++g) rs8[g] = S[(g >> 2) * 128 + wr * 64 + (g & 3) * 16 + fr];
#pragma unroll
    for (int bj = 0; bj < 2; ++bj) {
        f32x4 mul[2], add[2];
#pragma unroll
        for (int n = 0; n < 2; ++n) { mul[n] = ldg_f4(gam + 32 * bj + 4 * n) * (ldg_f4(modp + DM + 32 * bj + 4 * n) + 1.0f); add[n] = ldg_f4(modp + 32 * bj + 4 * n); }
#pragma unroll
        for (int g = 0; g < 8; ++g) { const int ai = g >> 2, m = g & 3;
            const f32x4 o0 = acc[ai][bj][m][0] * rs8[g] * mul[0] + add[0], o1 = acc[ai][bj][m][1] * rs8[g] * mul[1] + add[1];
            u32x4 w; w.x = cvt_pk_bf16(o0[0], o0[1]); w.y = cvt_pk_bf16(o0[2], o0[3]); w.z = cvt_pk_bf16(o1[0], o1[1]); w.w = cvt_pk_bf16(o1[2], o1[3]);
            stg_u4(hdb + GRP_OFF(g, 2) + (lo2 + 64u * bj), w); }
    }
#undef GRP_OFF
}

__device__ __forceinline__ void gemm_phase(const Frame& F, int gt, int l, int Geff) {
    LAS unsigned char* lds = F.lds;
    int tid = FTID(F); asm volatile("" : "+v"(tid));
    const int wid = F.wave, lane = tid & 63, wr = wid >> 2, wc = wid & 3, fr = lane & 15, fq = lane >> 4;
    int lda, ldb;
    switch (gt) { case GT_G1: case GT_G3: case GT_G4: case GT_G4M: lda = 2048; ldb = 2048; break; case GT_DFTPOS: case GT_G2: lda = 1024; ldb = 1024; break; default: lda = DFF; ldb = DFF; break; }
    unsigned voffA[2], voffB[2];
#pragma unroll
    for (int i = 0; i < 2; ++i) { int R, C; stage_rc(tid * 16 + i * 8192, R, C); voffA[i] = (unsigned)(R * lda + C) * 2u; voffB[i] = (unsigned)(R * ldb + C) * 2u; }
    const size_t kstep = (size_t)(BK * 2);
    const size_t hstepA = (size_t)HALF * lda * 2, hstepB = (size_t)HALF * ldb * 2;
    const unsigned ldsw = (unsigned)wid * 1024u;
    const int aoff = lds_byte(wr * 64 + fr, fq * 8), boff = lds_byte(wc * 32 + fr, fq * 8);
#define PG8_SA(b, h) (((b) * 2 + (h)) * HTB)
#define PG8_SB(b, h) ((4 + (b) * 2 + (h)) * HTB)
#define PG8_STAGE(bufoff, gbase, voff) do { _Pragma("unroll") for (int _i = 0; _i < 2; ++_i) \
        __builtin_amdgcn_global_load_lds((const GAS unsigned*)((gbase) + (voff)[_i]), (LAS unsigned*)(lds + (bufoff) + ldsw + _i * 8192), 16, 0, 0); } while (0)
#define PG8_LDA(dst, b, h) do { _Pragma("unroll") for (int m = 0; m < 4; ++m) _Pragma("unroll") for (int k = 0; k < 2; ++k) dst[m][k] = *(const LAS bf16x8*)(lds + PG8_SA(b, h) + aoff + m * 2048 + k * 1024); } while (0)
#define PG8_LDB(dst, b, h) do { _Pragma("unroll") for (int n = 0; n < 2; ++n) _Pragma("unroll") for (int k = 0; k < 2; ++k) dst[n][k] = *(const LAS bf16x8*)(lds + PG8_SB(b, h) + boff + n * 2048 + k * 1024); } while (0)
#define PG8_MMA(ai, bj, At, Bt) do { __builtin_amdgcn_s_setprio(1); _Pragma("unroll") for (int m = 0; m < 4; ++m) _Pragma("unroll") for (int n = 0; n < 2; ++n) _Pragma("unroll") for (int k = 0; k < 2; ++k) \
        acc[ai][bj][m][n] = __builtin_amdgcn_mfma_f32_16x16x32_bf16(Bt[n][k], At[m][k], acc[ai][bj][m][n], 0, 0, 0); __builtin_amdgcn_s_setprio(0); } while (0)
#define PG8_WAIT_V(n) asm volatile("s_waitcnt vmcnt(" #n ")" ::: "memory")
#define PG8_WAIT_L(n) asm volatile("s_waitcnt lgkmcnt(" #n ")" ::: "memory")
#define PG8_BAR __builtin_amdgcn_s_barrier()
#define PG8_SCHED __builtin_amdgcn_sched_barrier(0)
    Unit cur, nxt; int ui = 0;
    int g256 = F.G; asm volatile("" : "+s"(g256));
    const bool fused = (g256 == 256) && (gt == GT_G3 || (gt == GT_G5 && l == 0));
    if (!get_unit(F, gt, l, 0, Geff, cur)) return;
    f32x4 acc[2][2][4][2];
#pragma unroll
    for (int a = 0; a < 2; ++a)
#pragma unroll
        for (int b = 0; b < 2; ++b)
#pragma unroll
            for (int m = 0; m < 4; ++m)
#pragma unroll
                for (int n = 0; n < 2; ++n) acc[a][b][m][n] = (f32x4){0.f, 0.f, 0.f, 0.f};
    bf16x8 At[4][2], B0[2][2], B1[2][2];
    gcptr cA = cur.A; gcptr cB = cur.B;
    if constexpr (GEMM_SP2) {
        PG8_STAGE(PG8_SB(0, 0), cB, voffB); PG8_STAGE(PG8_SB(0, 1), cB + hstepB, voffB); PG8_STAGE(PG8_SA(0, 0), cA, voffA); PG8_STAGE(PG8_SA(0, 1), cA + hstepA, voffA);
        if (wr == 1) PG8_BAR;
        PG8_WAIT_V(2); PG8_BAR;
        PG8_STAGE(PG8_SB(1, 0), cB + kstep, voffB); PG8_STAGE(PG8_SA(1, 0), cA + kstep, voffA); PG8_STAGE(PG8_SB(1, 1), cB + hstepB + kstep, voffB);
        PG8_WAIT_V(6); PG8_BAR;
    } else {
    PG8_STAGE(PG8_SB(0, 0), cB, voffB); PG8_STAGE(PG8_SA(0, 0), cA, voffA); PG8_STAGE(PG8_SB(0, 1), cB + hstepB, voffB); PG8_STAGE(PG8_SA(0, 1), cA + hstepA, voffA);
    if (wr == 1) PG8_BAR;
    PG8_WAIT_V(4); PG8_BAR;
    PG8_STAGE(PG8_SB(1, 0), cB + kstep, voffB); PG8_STAGE(PG8_SA(1, 0), cA + kstep, voffA); PG8_STAGE(PG8_SB(1, 1), cB + hstepB + kstep, voffB);
    PG8_WAIT_V(6); PG8_BAR;
    }
    for (;;) {
        const bool has_next = get_unit(F, gt, l, ui + 1, Geff, nxt);
        gcptr nA = has_next ? nxt.A : cA; gcptr nB = has_next ? nxt.B : cB;
        const int nt = cur.nt;
        for (int t = 0; t < nt; t += 2) {
            const bool last = (t == nt - 2);
            gcptr a1 = cA + (size_t)(t + 1) * kstep;
            gcptr a2 = last ? nA : cA + (size_t)(t + 2) * kstep; gcptr b2 = last ? nB : cB + (size_t)(t + 2) * kstep;
            gcptr a3 = a2 + kstep; gcptr b3 = b2 + kstep;
            if constexpr (GEMM_SP2) {
            PG8_LDB(B0, 0, 0); PG8_LDB(B1, 0, 1); PG8_SCHED; PG8_LDA(At, 0, 0); PG8_STAGE(PG8_SA(1, 1), a1 + hstepA, voffA);
            PG8_WAIT_V(8); PG8_WAIT_L(0); PG8_BAR; PG8_MMA(0, 0, At, B0); PG8_MMA(0, 1, At, B1); PG8_BAR; PG8_SCHED;
            PG8_LDA(At, 0, 1); PG8_STAGE(PG8_SB(0, 0), b2, voffB); PG8_STAGE(PG8_SB(0, 1), b2 + hstepB, voffB); PG8_STAGE(PG8_SA(0, 0), a2, voffA);
            PG8_WAIT_V(8); PG8_WAIT_L(0); PG8_BAR; PG8_MMA(1, 0, At, B0); PG8_MMA(1, 1, At, B1); PG8_BAR; PG8_SCHED;
            PG8_LDB(B0, 1, 0); PG8_LDB(B1, 1, 1); PG8_SCHED; PG8_LDA(At, 1, 0); PG8_STAGE(PG8_SA(0, 1), a2 + hstepA, voffA);
            PG8_WAIT_V(8); PG8_WAIT_L(0); PG8_BAR; PG8_MMA(0, 0, At, B0); PG8_MMA(0, 1, At, B1); PG8_BAR; PG8_SCHED;
            PG8_LDA(At, 1, 1); PG8_STAGE(PG8_SB(1, 0), b3, voffB); PG8_STAGE(PG8_SB(1, 1), b3 + hstepB, voffB); PG8_STAGE(PG8_SA(1, 0), a3, voffA);
            PG8_WAIT_V(8); PG8_WAIT_L(0); PG8_BAR; PG8_MMA(1, 0, At, B0); PG8_MMA(1, 1, At, B1); PG8_BAR; PG8_SCHED;
            } else {
            PG8_LDB(B0, 0, 0); PG8_SCHED; PG8_LDA(At, 0, 0); PG8_STAGE(PG8_SA(1, 1), a1 + hstepA, voffA);
            PG8_WAIT_L(8); PG8_BAR; PG8_WAIT_L(0); PG8_MMA(0, 0, At, B0); PG8_BAR; PG8_SCHED;
            PG8_LDB(B1, 0, 1); PG8_STAGE(PG8_SB(0, 0), b2, voffB);
            PG8_BAR; PG8_WAIT_L(0); PG8_MMA(0, 1, At, B1); PG8_BAR;
            PG8_LDA(At, 0, 1); PG8_STAGE(PG8_SA(0, 0), a2, voffA);
            PG8_BAR; PG8_WAIT_L(0); PG8_MMA(1, 0, At, B0); PG8_BAR; PG8_SCHED;
            PG8_STAGE(PG8_SB(0, 1), b2 + hstepB, voffB);
            PG8_WAIT_V(6); PG8_BAR; PG8_MMA(1, 1, At, B1); PG8_BAR;
            PG8_LDB(B0, 1, 0); PG8_SCHED; PG8_LDA(At, 1, 0); PG8_STAGE(PG8_SA(0, 1), a2 + hstepA, voffA);
            PG8_WAIT_L(8); PG8_BAR; PG8_WAIT_L(0); PG8_MMA(0, 0, At, B0); PG8_BAR; PG8_SCHED;
            PG8_LDB(B1, 1, 1); PG8_STAGE(PG8_SB(1, 0), b3, voffB);
            PG8_BAR; PG8_WAIT_L(0); PG8_MMA(0, 1, At, B1); PG8_BAR;
            PG8_LDA(At, 1, 1); PG8_STAGE(PG8_SA(1, 0), a3, voffA);
            PG8_BAR; PG8_WAIT_L(0); PG8_MMA(1, 0, At, B0); PG8_BAR; PG8_SCHED;
            PG8_STAGE(PG8_SB(1, 1), b3 + hstepB, voffB);
            PG8_WAIT_V(6); PG8_BAR; PG8_MMA(1, 1, At, B1); PG8_BAR;
            }
        }
        if constexpr (GEMM_ALIGN_EPI) { if (wr == 0) PG8_BAR; }
        if (cur.kind == K_MIXA) mixa_scale(acc, cur, F, wr, wc, fr, fq);
        else if (!fused) epilogue(acc, cur, F, l, wr, wc, fr, fq);
        if (!has_next) break;
        if (cur.kind != K_MIXA) {
#pragma unroll
            for (int a = 0; a < 2; ++a)
#pragma unroll
                for (int b = 0; b < 2; ++b)
#pragma unroll
                    for (int m = 0; m < 4; ++m)
#pragma unroll
                        for (int n = 0; n < 2; ++n) acc[a][b][m][n] = (f32x4){0.f, 0.f, 0.f, 0.f};
        }
        cur = nxt; cA = nA; cB = nB; ++ui;
        if constexpr (GEMM_ALIGN_EPI) { if (wr == 1) PG8_BAR; }
    }
    PG8_WAIT_V(0);
    if constexpr (!GEMM_ALIGN_EPI) { if (wr == 0) PG8_BAR; }
    PG8_BAR;
    if (fused) fused_resnorm_epilogue(acc, cur, F, l, gt == GT_G3);
}

__device__ __forceinline__ void gemm_half_g4(const Frame& F, int l) {
    LAS unsigned char* lds = F.lds;
    int tid = FTID(F); asm volatile("" : "+v"(tid));
    const int wid = F.wave, lane = tid & 63, wr = wid >> 2, wc = wid & 3, fr = lane & 15, fq = lane >> 4;
    constexpr int lda = 2048, ldb = 2048, nt = 32;
    unsigned voffA[2], voffB[2];
#pragma unroll
    for (int i = 0; i < 2; ++i) { int R, C; stage_rc(tid * 16 + i * 8192, R, C); voffA[i] = (unsigned)(R * lda + C) * 2u; voffB[i] = (unsigned)(R * ldb + C) * 2u; }
    const size_t kstep = (size_t)(BK * 2), hstepB = (size_t)HALF * ldb * 2;
    const unsigned ldsw = (unsigned)wid * 1024u;
    const int aoff = lds_byte(wr * 64 + fr, fq * 8), boff = lds_byte(wc * 32 + fr, fq * 8);
    const int c = F.bid, hA = c & 1; int pm, pn; tile_order(1280 + (c >> 1), 32, 44, pm, pn);
    gcptr cA = (gcptr)F.ws + WS_H + (size_t)(pm * 256 + hA * 128) * DM * 2; gcptr cB = (gcptr)F.ws + WS_W + (size_t)l * W_LAYER + WO_GU + (size_t)pn * 256 * DM * 2;
    f32x4 acc[1][2][4][2];
#pragma unroll
    for (int b = 0; b < 2; ++b)
#pragma unroll
        for (int m = 0; m < 4; ++m)
#pragma unroll
            for (int n = 0; n < 2; ++n) acc[0][b][m][n] = (f32x4){0.f, 0.f, 0.f, 0.f};
    bf16x8 At[4][2], B0[2][2], B1[2][2];
    PG8_STAGE(PG8_SB(0, 0), cB, voffB); PG8_STAGE(PG8_SA(0, 0), cA, voffA); PG8_STAGE(PG8_SB(0, 1), cB + hstepB, voffB);
    if (wr == 1) PG8_BAR;
    PG8_WAIT_V(2); PG8_BAR;
    PG8_STAGE(PG8_SB(1, 0), cB + kstep, voffB); PG8_STAGE(PG8_SA(1, 0), cA + kstep, voffA);
    PG8_WAIT_V(6); PG8_BAR;
    for (int t = 0; t < nt; t += 2) {
        const int t2 = (t + 2 < nt) ? t + 2 : nt - 1, t3 = (t + 3 < nt) ? t + 3 : nt - 1;
        gcptr b1 = cB + (size_t)(t + 1) * kstep; gcptr a2 = cA + (size_t)t2 * kstep; gcptr b2 = cB + (size_t)t2 * kstep; gcptr a3 = cA + (size_t)t3 * kstep; gcptr b3 = cB + (size_t)t3 * kstep;
        PG8_LDB(B0, 0, 0); PG8_SCHED; PG8_LDA(At, 0, 0); PG8_STAGE(PG8_SB(1, 1), b1 + hstepB, voffB);
        PG8_WAIT_V(6); PG8_WAIT_L(0); PG8_BAR; PG8_MMA(0, 0, At, B0); PG8_BAR; PG8_SCHED;
        PG8_LDB(B1, 0, 1); PG8_STAGE(PG8_SB(0, 0), b2, voffB); PG8_STAGE(PG8_SA(0, 0), a2, voffA);
        PG8_WAIT_V(6); PG8_WAIT_L(0); PG8_BAR; PG8_MMA(0, 1, At, B1); PG8_BAR; PG8_SCHED;
        PG8_LDB(B0, 1, 0); PG8_SCHED; PG8_LDA(At, 1, 0); PG8_STAGE(PG8_SB(0, 1), b2 + hstepB, voffB);
        PG8_WAIT_V(6); PG8_WAIT_L(0); PG8_BAR; PG8_MMA(0, 0, At, B0); PG8_BAR; PG8_SCHED;
        PG8_LDB(B1, 1, 1); PG8_STAGE(PG8_SB(1, 0), b3, voffB); PG8_STAGE(PG8_SA(1, 0), a3, voffA);
        PG8_WAIT_V(6); PG8_WAIT_L(0); PG8_BAR; PG8_MMA(0, 1, At, B1); PG8_BAR; PG8_SCHED;
    }
    if (wr == 0) PG8_BAR;
    {
        int rt0 = wr * 64 + fr; asm volatile("" : "+v"(rt0));
        bf16_t* dst = (bf16_t*)(F.ws + WS_ACT) + (size_t)(pm * 256 + hA * 128 + rt0) * DFF + pn * 128 + wc * 32 + fq * 8;
#pragma unroll
        for (int m = 0; m < 4; ++m) { float o[8];
#pragma unroll
            for (int e = 0; e < 8; ++e) { const float a = acc[0][0][m][e >> 2][e & 3], g = acc[0][1][m][e >> 2][e & 3]; o[e] = a * g * sigmoidf_(g); }
            u32x4 w; w.x = cvt_pk_bf16(o[0], o[1]); w.y = cvt_pk_bf16(o[2], o[3]); w.z = cvt_pk_bf16(o[4], o[5]); w.w = cvt_pk_bf16(o[6], o[7]);
            stg_u4(dst + (size_t)(m * 16) * DFF, w); }
    }
    PG8_WAIT_V(0);
    PG8_BAR;
}
#undef PG8_SA
#undef PG8_SB
#undef PG8_STAGE
#undef PG8_LDA
#undef PG8_LDB
#undef PG8_MMA
#undef PG8_WAIT_V
#undef PG8_WAIT_L
#undef PG8_BAR
#undef PG8_SCHED

__device__ __forceinline__ int dst_row_std(int nn) { return (nn & ~255) + rho256(nn & 255); }
__device__ __forceinline__ int dst_row_glu(int nn) { const int half = nn >= DFF ? 1 : 0, cc = nn - half * DFF, pn = cc >> 7, L = cc & 127;
    return pn * 256 + 128 * half + 32 * (L >> 5) + 16 * ((L >> 2) & 1) + 4 * ((L >> 3) & 3) + (L & 3); }
constexpr int TR_SCR_BYTES = 64 * 65 * 4;
constexpr int I_IN = (DM / 64) * (4096 / 64), I_NA = (1024 / 64) * (DM / 64), I_O = (DM / 64) * (DM / 64), I_GU = (DM / 64) * (2 * DFF / 64), I_D = (DFF / 64) * (DM / 64);
constexpr int I_LAYER = 2 * I_IN + 2 * I_NA + I_O + I_GU + I_D, I_EARLY = 2 * I_IN;
struct TItem { const float* W; bf16_t* WT; int K, N, mode, row_off, k0, n0; };
__device__ __forceinline__ TItem titem_decode(const Frame& F, int it) {
    TItem t; unsigned char* ws = F.ws; const int l = it / I_LAYER; int r = it % I_LAYER; unsigned char* wl = ws + WS_W + (size_t)l * W_LAYER;
    t.mode = 0; t.row_off = 0;
    if (r < I_IN) { t.W = FIN(IN_WIN) + (size_t)l * DM * 4096; t.K = DM; t.N = 4096; t.WT = (bf16_t*)(wl + WO_W1); }
    else if ((r -= I_IN) < I_IN) { t.W = FIN(IN_WGATE) + (size_t)l * DM * 4096; t.K = DM; t.N = 4096; t.WT = (bf16_t*)(wl + WO_W1); t.row_off = 4096; }
    else if ((r -= I_IN) < I_NA) { t.W = FIN(IN_WNA) + (size_t)l * 1024 * DM; t.K = 1024; t.N = DM; t.WT = (bf16_t*)(wl + WO_NA); }
    else if ((r -= I_NA) < I_NA) { t.W = FIN(IN_WFN) + (size_t)l * 1024 * DM; t.K = 1024; t.N = DM; t.WT = (bf16_t*)(wl + WO_FN); }
    else if ((r -= I_NA) < I_O) { t.W = FIN(IN_WO) + (size_t)l * DM * DM; t.K = DM; t.N = DM; t.WT = (bf16_t*)(wl + WO_O); }
    else if ((r -= I_O) < I_GU) { t.W = FIN(IN_WGU) + (size_t)l * DM * 2 * DFF; t.K = DM; t.N = 2 * DFF; t.WT = (bf16_t*)(wl + WO_GU); t.mode = 1; }
    else { r -= I_GU; t.W = FIN(IN_WD) + (size_t)l * DFF * DM; t.K = DFF; t.N = DM; t.WT = (bf16_t*)(wl + WO_D); }
    const int nblk = t.N / 64; t.k0 = 64 * (r / nblk); t.n0 = 64 * (r % nblk);
    return t;
}
__device__ __forceinline__ void titem_load(const TItem& t, int lane, f32x4 (&wv)[16]) {
    const float* wp = t.W + (size_t)(t.k0 + (lane >> 4)) * t.N + t.n0 + 4 * (lane & 15);
#pragma unroll
    for (int i = 0; i < 16; ++i) wv[i] = *(const f32x4*)(wp + (size_t)(4 * i) * t.N);
}
__device__ __forceinline__ void titem_finish(const TItem& t, int lane, const f32x4 (&wv)[16], LAS float* scr) {
    const int rr = lane >> 4, c4 = lane & 15;
#pragma unroll
    for (int i = 0; i < 16; ++i) { LAS float* d = scr + (4 * i + rr) * 65 + 4 * c4; d[0] = wv[i][0]; d[1] = wv[i][1]; d[2] = wv[i][2]; d[3] = wv[i][3]; }
    LDS_WAIT();
    const int c = lane & 7;
#pragma unroll
    for (int j = 0; j < 8; ++j) { const int n = (lane >> 3) + 8 * j; const LAS float* sp = scr + (8 * c) * 65 + n;
        u32x4 o; o.x = cvt_pk_bf16(sp[0 * 65], sp[1 * 65]); o.y = cvt_pk_bf16(sp[2 * 65], sp[3 * 65]); o.z = cvt_pk_bf16(sp[4 * 65], sp[5 * 65]); o.w = cvt_pk_bf16(sp[6 * 65], sp[7 * 65]);
        const int dr = t.row_off + (t.mode ? dst_row_glu(t.n0 + n) : dst_row_std(t.n0 + n));
        *(u32x4*)(t.WT + (size_t)dr * t.K + t.k0 + 8 * c) = o; }
    LDS_WAIT();
}
__device__ __forceinline__ void convert_range(const Frame& F, int lo, int hi, int gwv, int nwv) {
    int lane_ = FTID(F); asm volatile("" : "+v"(lane_)); lane_ &= 63;
    LAS float* scr = (LAS float*)(F.lds + F.wave * TR_SCR_BYTES);
    for (int it = lo + gwv; it < hi; it += 2 * nwv) {
        const int itb = it + nwv; const bool hb = itb < hi;
        const TItem a = titem_decode(F, it), b = titem_decode(F, hb ? itb : it);
        f32x4 va[16], vb[16];
        titem_load(a, lane_, va); titem_load(b, lane_, vb);
        titem_finish(a, lane_, va, scr);
        if (hb) titem_finish(b, lane_, vb, scr);
    }
}

__device__ __forceinline__ void p0_phase(const Frame& F) {
    unsigned char* ws = F.ws;
    int tid_ = FTID(F); asm volatile("" : "+v"(tid_)); const int lane_ = tid_ & 63;
    for (int item = F.bid; item < 256; item += F.G) {
        const int l = item >> 7, col0 = (item & 127) * 96;
        LAS float* S = (LAS float*)F.lds;
        LAS float* R = (LAS float*)(F.lds + 40960);
        for (int idx = tid_; idx < 5 * DM; idx += 512) { const int cnd = idx >> 11, k = idx & 2047; const float v = cnd < 4 ? FIN(IN_C)[cnd * DM + k] : FIN(IN_CCTX)[k]; S[idx] = v * sigmoidf_(v); }
        __syncthreads();
        const int sub = lane_ / 24, lc = lane_ - sub * 24, rsel = sub >= 1 ? 1 : 0;
        f32x4 a[5];
#pragma unroll
        for (int cnd = 0; cnd < 5; ++cnd) a[cnd] = (f32x4){0.f, 0.f, 0.f, 0.f};
        const float* wp = FIN(IN_WMOD) + ((size_t)l * DM + F.wave * 256 + rsel) * NMOD + col0 + 4 * lc;
        LAS const float* Sw = S + F.wave * 256 + rsel;
        for (int kk = 0; kk < 256; kk += 16) {
            f32x4 wv[8];
#pragma unroll
            for (int j = 0; j < 8; ++j) wv[j] = *(const f32x4*)(wp + (size_t)(kk + 2 * j) * NMOD);
#pragma unroll
            for (int j = 0; j < 8; ++j) {
#pragma unroll
                for (int cnd = 0; cnd < 5; ++cnd) { const float sv = Sw[cnd * DM + kk + 2 * j]; a[cnd] += wv[j] * sv; } }
        }
        if (sub < 2) {
#pragma unroll
            for (int cnd = 0; cnd < 5; ++cnd) *(LAS f32x4*)(R + ((F.wave * 2 + rsel) * 5 + cnd) * 96 + 4 * lc) = a[cnd]; }
        __syncthreads();
        for (int idx = tid_; idx < 5 * 96; idx += 512) { const int cnd = idx / 96, col = idx - cnd * 96; float sacc = FIN(IN_BMOD)[l * NMOD + col0 + col];
#pragma unroll
            for (int p = 0; p < 16; ++p) sacc += R[(p * 5 + cnd) * 96 + col];
            ((float*)(ws + WS_MOD))[(size_t)(l * 5 + cnd) * NMOD + col0 + col] = sacc; }
        __syncthreads();
    }
    const int gw = F.bid * 8 + F.wave, NGW = F.G * 8;
    constexpr int C_CACHE = 4 * 2 * 256 * 1024 / 512, C_DT1024 = 2 * 1024 * 1024 / 512, C_DT256 = 2 * 256 * 256 / 512, C_DCT = 256 * 512 / 512;
    int ch0 = gw;
    if (F.G == 256) {
        f32x4 xa[4][2];
#pragma unroll
        for (int i = 0; i < 4; ++i) { const int r = gw + i * 2048, which = r / C_CACHE; const size_t e = (size_t)(r % C_CACHE) * 512 + lane_ * 8; const float* src = (which ? FIN(IN_CV) : FIN(IN_CK)) + e;
            xa[i][0] = *(const f32x4*)src; xa[i][1] = *(const f32x4*)(src + 4); }
#pragma unroll
        for (int i = 0; i < 4; ++i) { const int r = gw + i * 2048, which = r / C_CACHE; const size_t e = (size_t)(r % C_CACHE) * 512 + lane_ * 8;
            u32x4 o; o.x = cvt_pk_bf16(xa[i][0][0], xa[i][0][1]); o.y = cvt_pk_bf16(xa[i][0][2], xa[i][0][3]); o.z = cvt_pk_bf16(xa[i][1][0], xa[i][1][1]); o.w = cvt_pk_bf16(xa[i][1][2], xa[i][1][3]);
            *(u32x4*)((bf16_t*)(ws + (which ? WS_CV : WS_CK)) + e) = o; }
        ch0 = gw + 4 * 2048;
    }
    for (int ch = ch0; ch < 2 * C_CACHE + C_DT1024 + C_DT256 + C_DCT; ch += NGW) {
        int r = ch; float v[8]; bf16_t* dst;
        if (r < 2 * C_CACHE) { const int which = r / C_CACHE; const size_t e = (size_t)(r % C_CACHE) * 512 + lane_ * 8; const float* src = (which ? FIN(IN_CV) : FIN(IN_CK)) + e;
            const f32x4 x0 = *(const f32x4*)src, x1 = *(const f32x4*)(src + 4); v[0] = x0[0]; v[1] = x0[1]; v[2] = x0[2]; v[3] = x0[3]; v[4] = x1[0]; v[5] = x1[1]; v[6] = x1[2]; v[7] = x1[3];
            dst = (bf16_t*)(ws + (which ? WS_CV : WS_CK)) + e; }
        else { r -= 2 * C_CACHE;
            if (r < C_DT1024) { const int e = r * 512 + lane_ * 8, cs = e >> 20, t = (e >> 10) & 1023, t0 = e & 1023;
#pragma unroll
                for (int j = 0; j < 8; ++j) { const int mm = (t * (t0 + j)) & 1023; const float x = (float)mm * (2.0f / 1024.0f); v[j] = (cs ? sinpif(x) : cospif(x)) * (1.0f / 32.0f); }
                dst = (bf16_t*)(ws + WS_DT1024) + e; }
            else { r -= C_DT1024;
                if (r < C_DT256) { const int e = r * 512 + lane_ * 8, cs = e >> 16, t = (e >> 8) & 255, t0 = e & 255;
#pragma unroll
                    for (int j = 0; j < 8; ++j) { const int mm = (t * (t0 + j)) & 255; const float x = (float)mm * (2.0f / 256.0f); v[j] = (cs ? sinpif(x) : cospif(x)) * (1.0f / 16.0f); }
                    dst = (bf16_t*)(ws + WS_DT256) + ((size_t)(cs * 256 + t) * 1024 + t0); }
                else { r -= C_DT256; const int e = r * 512 + lane_ * 8, row = e >> 9, col = e & 511, mlog = rho256_inv(row);
#pragma unroll
                    for (int j = 0; j < 8; ++j) { const int cc = col + j, cch = cc & 255, mm = (mlog * cch) & 255; const float x = (float)mm * (2.0f / 256.0f); v[j] = (cc < 256 ? cospif(x) : -sinpif(x)) * (1.0f / 16.0f); }
                    dst = (bf16_t*)(ws + WS_DCT) + (size_t)row * 1024 + col; } } }
        u32x4 o; o.x = cvt_pk_bf16(v[0], v[1]); o.y = cvt_pk_bf16(v[2], v[3]); o.z = cvt_pk_bf16(v[4], v[5]); o.w = cvt_pk_bf16(v[6], v[7]);
        *(u32x4*)dst = o;
    }
}

__device__ __forceinline__ float wave_sum(float v) {
#pragma unroll
    for (int o = 1; o < 64; o <<= 1) v += __shfl_xor(v, o);
    return v;
}
__device__ __forceinline__ void norm_phase(const Frame& F, int l, int which) {
    unsigned char* ws = F.ws;
    int lane = FTID(F); asm volatile("" : "+v"(lane)); lane &= 63;
    const int gw = F.bid * 8 + F.wave, NGW = F.G * 8;
    const float* gam = (which ? FIN(IN_N2) : FIN(IN_N1)) + l * DM;
    for (int row0 = gw; row0 < NTOK; row0 += 2 * NGW) {
        f32x4 v[2][8]; float ss[2] = {0.f, 0.f}; const int row1 = row0 + NGW;
#pragma unroll
        for (int r = 0; r < 2; ++r) { const int row = r ? row1 : row0; if (row < NTOK) {
            const float* xr;
            if (which) xr = (const float*)(ws + WS_X1) + (size_t)row * DM;
            else if (l == 0) xr = row < NPR ? FIN(IN_XP) + (size_t)row * DM : FIN(IN_XS) + (size_t)(row - NPR) * DM;
            else xr = (const float*)(ws + WS_X2) + (size_t)row * DM;
#pragma unroll
            for (int j = 0; j < 8; ++j) v[r][j] = *(const f32x4*)(xr + 256 * j + 4 * lane); } }
#pragma unroll
        for (int r = 0; r < 2; ++r) { const int row = r ? row1 : row0; if (row < NTOK) {
#pragma unroll
            for (int j = 0; j < 8; ++j) ss[r] += (v[r][j][0] * v[r][j][0] + v[r][j][1] * v[r][j][1]) + (v[r][j][2] * v[r][j][2] + v[r][j][3] * v[r][j][3]);
            const float rstd = __builtin_amdgcn_rsqf(wave_sum(ss[r]) * (1.0f / DM) + EPS);
            const int cond = row < NPR ? 4 : ((row - NPR) >> 10);
            const float* mod = (const float*)(ws + WS_MOD) + (size_t)(l * 5 + cond) * NMOD + (which ? 3 : 0) * DM;
            bf16_t* orow = (bf16_t*)(ws + WS_H) + (size_t)row * DM;
#pragma unroll
            for (int j = 0; j < 8; ++j) { const int c0 = 256 * j + 4 * lane;
                const f32x4 g = *(const f32x4*)(gam + c0), sh = *(const f32x4*)(mod + c0), sc = *(const f32x4*)(mod + DM + c0);
                const f32x4 o = v[r][j] * rstd * g * (sc + 1.0f) + sh;
                u32x2 w; w.x = cvt_pk_bf16(o[0], o[1]); w.y = cvt_pk_bf16(o[2], o[3]); *(u32x2*)(orow + c0) = w; } } }
    }
}

__device__ __forceinline__ unsigned vswz(int row, int byte) { return (unsigned)(row * 128 + ((((byte >> 4) ^ (((row >> 1) & 3) << 1)) << 4) | (byte & 15))); }
__device__ __forceinline__ s16x4 vtr(LAS const unsigned char* p) { return __builtin_bit_cast(s16x4, __builtin_amdgcn_ds_read_tr16_b64_v4i16((LAS v4i16_t*)p)); }

struct AttnState { float m, lsum; f32x4 o[4]; };

template <bool LOCAL, bool KLDS>
__device__ __forceinline__ void attn_chunk(AttnState& st, const bf16x8 (&qf)[2], const bf16_t* kp, const unsigned (&klds)[2], LAS const unsigned char* vbase, int vrow0, const unsigned (&voff)[4],
                                           LAS const float* rpbL, int qc, int wsq, int cs, int drbase, int fq) {
    f32x4 s[16];
#define KOFF(kb) (LOCAL ? ((size_t)(((kb) >> 1) * 64 + ((kb) & 1) * 16) * 1024) : ((size_t)(kb) * 16 * 1024))
#define VROW(kb) (LOCAL ? (vrow0 + ((kb) >> 1) * 64 + ((kb) & 1) * 16) : (vrow0 + (kb) * 16))
    {
        bf16x8 kf[16][2];
#pragma unroll
        for (int kb = 0; kb < 16; ++kb) {
            if (KLDS) { kf[kb][0] = *(LAS const bf16x8*)(vbase + klds[0] + kb * 2048); kf[kb][1] = *(LAS const bf16x8*)(vbase + klds[1] + kb * 2048); }
            else { const bf16_t* p = kp + KOFF(kb); kf[kb][0] = *(const bf16x8*)p; kf[kb][1] = *(const bf16x8*)(p + 32); } }
#pragma unroll
        for (int kb = 0; kb < 16; ++kb) { f32x4 z = (f32x4){0.f, 0.f, 0.f, 0.f};
            z = __builtin_amdgcn_mfma_f32_16x16x32_bf16(kf[kb][0], qf[0], z, 0, 0, 0);
            s[kb] = __builtin_amdgcn_mfma_f32_16x16x32_bf16(kf[kb][1], qf[1], z, 0, 0, 0); }
    }
    asm volatile("" ::: "memory");
    if (LOCAL) {
#pragma unroll
        for (int kb = 0; kb < 16; ++kb) {
            const int dr = drbase + (kb >> 1);
#pragma unroll
            for (int r = 0; r < 4; ++r) { const int kc = cs + 16 * (kb & 1) + 4 * fq + r; const int dc = iclamp(kc - qc + 15, 0, 30);
                float b = rpbL[dr * 31 + dc]; asm volatile("" : "+v"(b));
                const bool ok = (unsigned)(kc - wsq) < 16u;
                s[kb][r] = ok ? s[kb][r] + b : -__builtin_inff(); }
        }
    }
    float mx = -__builtin_inff();
#pragma unroll
    for (int kb = 0; kb < 16; ++kb) mx = fmaxf(fmaxf(mx, fmaxf(s[kb][0], s[kb][1])), fmaxf(s[kb][2], s[kb][3]));
    mx = fmaxf(mx, __shfl_xor(mx, 16)); mx = fmaxf(mx, __shfl_xor(mx, 32));
    const float mnew = fmaxf(st.m, mx);
    const float alpha = fexp2((st.m - mnew) * LOG2E);
    st.m = mnew; st.lsum *= alpha;
#pragma unroll
    for (int d = 0; d < 4; ++d) st.o[d] = st.o[d] * alpha;
    const float mb = mnew * LOG2E;
    float ps = 0.f;
#pragma unroll
    for (int ks = 0; ks < 8; ++ks) {
        float p[8];
#pragma unroll
        for (int r = 0; r < 4; ++r) { p[r] = fexp2(s[2 * ks][r] * LOG2E - mb); p[4 + r] = fexp2(s[2 * ks + 1][r] * LOG2E - mb); }
        ps += ((p[0] + p[1]) + (p[2] + p[3])) + ((p[4] + p[5]) + (p[6] + p[7]));
        u32x4 pw; pw.x = cvt_pk_bf16(p[0], p[1]); pw.y = cvt_pk_bf16(p[2], p[3]); pw.z = cvt_pk_bf16(p[4], p[5]); pw.w = cvt_pk_bf16(p[6], p[7]);
        const bf16x8 pf = __builtin_bit_cast(bf16x8, pw);
        LAS const unsigned char* v0 = vbase + VROW(2 * ks) * 128; LAS const unsigned char* v1 = vbase + VROW(2 * ks + 1) * 128;
#pragma unroll
        for (int d = 0; d < 4; ++d) { const s16x4 a0 = vtr(v0 + voff[d]), a1 = vtr(v1 + voff[d]);
            bf16x8 af; af[0] = a0[0]; af[1] = a0[1]; af[2] = a0[2]; af[3] = a0[3]; af[4] = a1[0]; af[5] = a1[1]; af[6] = a1[2]; af[7] = a1[3];
            st.o[d] = __builtin_amdgcn_mfma_f32_16x16x32_bf16(af, pf, st.o[d], 0, 0, 0); }
        if (ks & 1) asm volatile("" ::: "memory");
    }
    st.lsum += ps;
#undef KOFF
#undef VROW
}

__device__ __forceinline__ void attn_phase(const Frame& F, int l) {
    unsigned char* ws = F.ws; LAS unsigned char* lds = F.lds;
    const int w = F.wave;
    const bf16_t* Qb = (const bf16_t*)(ws + WS_Q); const bf16_t* Kb = (const bf16_t*)(ws + WS_K); const bf16_t* Vb = (const bf16_t*)(ws + WS_V);
    bf16_t* Ob = (bf16_t*)(ws + WS_ATT);
    constexpr int VCTX_ROW0 = 576, KCTX_OFF = (576 + 256) * 128, RPB_OFF = KCTX_OFF + 32768;
    const int qx = F.bid & 7;
    unsigned* qctr = (unsigned*)(ws + WS_CTL + 98304) + (l * 8 + qx) * 64;
    volatile LAS int* QN = (volatile LAS int*)(lds + LDSCTL_OFF + 256);
    if (FTID(F) == 0) QN[0] = (int)__hip_atomic_fetch_add(qctr, 1u, __ATOMIC_RELAXED, __HIP_MEMORY_SCOPE_AGENT);
    __syncthreads();
    int qe = QN[0];
    while (qe < 128) {
        int nxt_ = 0;
        const int item = qe < 64 ? 64 * qx + qe : 512 + 64 * qx + (qe - 64);
        __syncthreads();
        int tid = FTID(F); asm volatile("" : "+v"(tid));
        if (tid == 0) nxt_ = (int)__hip_atomic_fetch_add(qctr, 1u, __ATOMIC_RELAXED, __HIP_MEMORY_SCOPE_AGENT);
        const int lane = tid & 63, i16 = lane & 15, fq = lane >> 4;
        unsigned voff[4];
        { const int qp = i16 >> 2, p = i16 & 3; const int sw = ((2 * fq + (qp >> 1)) & 3) << 1;
#pragma unroll
          for (int d = 0; d < 4; ++d) voff[d] = (unsigned)((4 * fq + qp) * 128 + ((8 * p) & 15) + ((p >> 1) << 4) + (((2 * d) ^ sw) << 4)); }
        unsigned klds[2];
#pragma unroll
        for (int sx = 0; sx < 2; ++sx) klds[sx] = (unsigned)(KCTX_OFF + i16 * 128 + (((4 * sx + fq) ^ (i16 & 7)) << 4));
        if (item < 512) {
            const int b = item >> 7, h = (item >> 3) & 15, rp = item & 7;
            const int rs2 = iclamp(2 * rp - 4, 0, 8); const int nrows = (rs2 + 9 > 16 ? 16 - rs2 : 9) * 64;
            const int tokb = NPR + b * 1024;
            {
                const int r0 = tid >> 3, ch = tid & 7; u32x4 xl[9], xc[4], xk[4];
                const bf16_t* ksrc = (const bf16_t*)(ws + WS_CK) + (size_t)((b * 2 + l) * 256 + r0) * 1024 + h * 64 + ch * 8;
                const bf16_t* vsrc = Vb + (size_t)(tokb + rs2 * 64 + r0) * 1024 + h * 64 + ch * 8;
                const bf16_t* csrc = (const bf16_t*)(ws + WS_CV) + (size_t)((b * 2 + l) * 256 + r0) * 1024 + h * 64 + ch * 8;
#pragma unroll
                for (int k = 0; k < 9; ++k) xl[k] = *(const u32x4*)(vsrc + (size_t)((64 * k < nrows) ? k : 0) * 64 * 1024);
#pragma unroll
                for (int k = 0; k < 4; ++k) { xc[k] = *(const u32x4*)(csrc + (size_t)k * 64 * 1024); xk[k] = *(const u32x4*)(ksrc + (size_t)k * 64 * 1024); }
#pragma unroll
                for (int k = 0; k < 9; ++k) if (64 * k < nrows) *(LAS u32x4*)(lds + vswz(r0 + 64 * k, ch * 16)) = xl[k];
#pragma unroll
                for (int k = 0; k < 4; ++k) { *(LAS u32x4*)(lds + vswz(VCTX_ROW0 + r0 + 64 * k, ch * 16)) = xc[k]; *(LAS u32x4*)(lds + KCTX_OFF + (r0 + 64 * k) * 128 + ((ch ^ (r0 & 7)) << 4)) = xk[k]; }
            }
            const float* rp_g = FIN(IN_RPB) + (size_t)(l * 16 + h) * 465;
            for (int idx = tid; idx < 465; idx += 512) ((LAS float*)(lds + RPB_OFF))[idx] = rp_g[idx];
            if (tid == 0) QN[0] = nxt_;
            __syncthreads();
            nxt_ = QN[0];
            const int r = 2 * rp + (w >> 2), n = w & 3;
            const int rs = iclamp(r - 4, 0, 8), cs = iclamp(16 * n - 8, 0, 32);
            const int qtok = tokb + r * 64 + 16 * n + i16;
            bf16x8 qf[2]; { const bf16_t* qp = Qb + (size_t)qtok * 1024 + h * 64 + 8 * fq; qf[0] = *(const bf16x8*)qp; qf[1] = *(const bf16x8*)(qp + 32); }
            int qc = 16 * n + i16; asm volatile("" : "+v"(qc));
            const int wsq = iclamp(qc - 8, 0, 48);
            AttnState st; st.m = -__builtin_inff(); st.lsum = 0.f;
#pragma unroll
            for (int d = 0; d < 4; ++d) st.o[d] = (f32x4){0.f, 0.f, 0.f, 0.f};
            const bf16_t* kpl = Kb + (size_t)(tokb + rs * 64 + cs + i16) * 1024 + h * 64 + 8 * fq;
            attn_chunk<true, false>(st, qf, kpl, klds, lds, (rs - rs2) * 64 + cs, voff, (LAS const float*)(lds + RPB_OFF), qc, wsq, cs, rs - r + 7, fq);
            attn_chunk<false, true>(st, qf, nullptr, klds, lds, VCTX_ROW0, voff, nullptr, 0, 0, 0, 0, fq);
            float lt = st.lsum; lt += __shfl_xor(lt, 16); lt += __shfl_xor(lt, 32);
            const float inv = 1.0f / lt;
            bf16_t* op = Ob + (size_t)qtok * 1024 + h * 64 + 4 * fq;
#pragma unroll
            for (int d = 0; d < 4; ++d) { const f32x4 o = st.o[d] * inv; u32x2 wv; wv.x = cvt_pk_bf16(o[0], o[1]); wv.y = cvt_pk_bf16(o[2], o[3]); *(u32x2*)(op + 16 * d) = wv; }
        } else {
            const int x = item - 512, b = x >> 5, h = (x >> 1) & 15, qh = x & 1;
            { const int r0 = tid >> 3, ch = tid & 7; u32x4 xc[4], xk[4]; const bf16_t* vsrc = Vb + (size_t)(b * 256 + r0) * 1024 + h * 64 + ch * 8; const bf16_t* ksrc = Kb + (size_t)(b * 256 + r0) * 1024 + h * 64 + ch * 8;
#pragma unroll
                for (int k = 0; k < 4; ++k) { xc[k] = *(const u32x4*)(vsrc + (size_t)k * 64 * 1024); xk[k] = *(const u32x4*)(ksrc + (size_t)k * 64 * 1024); }
#pragma unroll
                for (int k = 0; k < 4; ++k) { *(LAS u32x4*)(lds + vswz(r0 + 64 * k, ch * 16)) = xc[k]; *(LAS u32x4*)(lds + KCTX_OFF + (r0 + 64 * k) * 128 + ((ch ^ (r0 & 7)) << 4)) = xk[k]; } }
            if (tid == 0) QN[0] = nxt_;
            __syncthreads();
            nxt_ = QN[0];
            const int qtok = b * 256 + qh * 128 + 16 * w + i16;
            bf16x8 qf[2]; { const bf16_t* qp = Qb + (size_t)qtok * 1024 + h * 64 + 8 * fq; qf[0] = *(const bf16x8*)qp; qf[1] = *(const bf16x8*)(qp + 32); }
            AttnState st; st.m = -__builtin_inff(); st.lsum = 0.f;
#pragma unroll
            for (int d = 0; d < 4; ++d) st.o[d] = (f32x4){0.f, 0.f, 0.f, 0.f};
            attn_chunk<false, true>(st, qf, nullptr, klds, lds, 0, voff, nullptr, 0, 0, 0, 0, fq);
            float lt = st.lsum; lt += __shfl_xor(lt, 16); lt += __shfl_xor(lt, 32);
            const float inv = 1.0f / lt;
            bf16_t* op = Ob + (size_t)qtok * 1024 + h * 64 + 4 * fq;
#pragma unroll
            for (int d = 0; d < 4; ++d) { const f32x4 o = st.o[d] * inv; u32x2 wv; wv.x = cvt_pk_bf16(o[0], o[1]); wv.y = cvt_pk_bf16(o[2], o[3]); *(u32x2*)(op + 16 * d) = wv; }
        }
        qe = __builtin_amdgcn_readfirstlane(nxt_);
    }
    __syncthreads();
}

constexpr int N_PHASES = 17;
__global__ void __launch_bounds__(512, 2) mk_fwd(Args args) {
    extern __shared__ __attribute__((aligned(16))) unsigned char lds_raw[];
    Frame F;
    F.lds = (LAS unsigned char*)lds_raw;
    F.wave = __builtin_amdgcn_readfirstlane((int)threadIdx.x >> 6); F.G = gridDim.x; F.bid = blockIdx.x;
    F.out = args.out; F.ws = args.ws;
    volatile LAS unsigned* MISC = (volatile LAS unsigned*)(F.lds + LDSCTL_OFF);
    for (int u = FTID(F); u < 2048 / 4; u += 512) ((LAS unsigned*)(F.lds + LDSCTL_OFF))[u] = 0u;
    __syncthreads();
    const int lo = args.ph_lo, hi = args.ph_hi;
    XcdBarrier bar; bar.bar = (unsigned*)(F.ws + WS_CTL); bar.x = 0; bar.st = nullptr;
    if (hi - lo > 1) bar = xcd_barrier_post((unsigned*)(F.ws + WS_CTL), MISC + 8);
#ifndef MK_REPEAT_PH
#define MK_REPEAT_PH -1
#endif
    for (int pp = lo; pp < hi + (MK_REPEAT_PH >= 0 ? 1 : 0); ++pp) {
        const int ph = (MK_REPEAT_PH >= 0 && pp > MK_REPEAT_PH) ? pp - 1 : pp;
        int g256 = F.G; asm volatile("" : "+s"(g256));
        const bool split = (g256 == 256);
        constexpr int NGEMM1 = 205, NGEMM4 = 235, NLATE = 7000;
        int cv_lo = 0, cv_hi = 0, cv_gw = 0, cv_n = 1;
        if (ph == 0) { p0_phase(F); cv_hi = split ? I_EARLY : 2 * I_LAYER; cv_gw = F.bid * 8 + F.wave; cv_n = F.G * 8; }
        else {
            const int l = (ph - 1) / 8, s = (ph - 1) % 8;
            const bool fusedn = (g256 == 256);
            if (fusedn && (s == 5 || (s == 0 && l == 1))) continue;
            if (s == 0) norm_phase(F, l, 0);
            if (s == 5) norm_phase(F, l, 1);
            int gt = -1, geff = F.G;
            if (s == 1) gt = GT_G1; else if (s == 2) gt = GT_DFTPOS; else if (s == 3) gt = GT_G2; else if (s == 4) gt = GT_G3; else if (s == 6) gt = GT_G4; else if (s == 7) gt = GT_G5;
            if (split && ph == 2) { geff = NGEMM1; if (F.bid >= NGEMM1) { gt = -1; cv_lo = I_EARLY; cv_hi = 2 * I_LAYER - NLATE; cv_gw = (F.bid - NGEMM1) * 8 + F.wave; cv_n = (256 - NGEMM1) * 8; } }
            if (split && ph == 7) { geff = NGEMM4; if (F.bid >= NGEMM4) { gt = -1; cv_lo = 2 * I_LAYER - NLATE; cv_hi = 2 * I_LAYER; cv_gw = (F.bid - NGEMM4) * 8 + F.wave; cv_n = (256 - NGEMM4) * 8; } }
#ifndef MK_ATTN_REP
#define MK_ATTN_REP 1
#endif
#ifndef MK_DFT_REP
#define MK_DFT_REP 1
#endif
            int nrep_g = (s == 2) ? MK_DFT_REP : 1, nrep_a = MK_ATTN_REP; asm volatile("" : "+s"(nrep_g), "+s"(nrep_a));
            const bool g4h = split && (ph == 15);
            if (g4h) gt = GT_G4M;
            if (gt >= 0) for (int rep = 0; rep < nrep_g; ++rep) gemm_phase(F, gt, l, geff);
            if (g4h) gemm_half_g4(F, l);
            if (s == 2) for (int rep = 0; rep < nrep_a; ++rep) attn_phase(F, l);
        }
        if (cv_hi > cv_lo) convert_range(F, cv_lo, cv_hi, cv_gw, cv_n);
        if (ph + 1 < hi) xcd_barrier(bar);
    }
}


#if defined(MK_DEBUG_CHECK)
__device__ __forceinline__ float bf2f(bf16_t v) { return __uint_as_float(((unsigned)v) << 16); }
__device__ __forceinline__ float f2bf2f(float f) { unsigned u = __float_as_uint(f); u += 0x7fffu + ((u >> 16) & 1u); return __uint_as_float(u & 0xffff0000u); }
__device__ __forceinline__ unsigned hash32(unsigned x) { x ^= x >> 16; x *= 0x7feb352dU; x ^= x >> 15; x *= 0x846ca68bU; x ^= x >> 16; return x; }
__device__ __forceinline__ void dbg_report(unsigned* slot, float e) { if (!(e >= 0.f)) e = 1e30f; atomicMax(slot, __float_as_uint(e)); }
__global__ void __launch_bounds__(64) dbg_check(Args a, int mode, int l) {
    const unsigned sid = blockIdx.x * blockDim.x + threadIdx.x; const unsigned hs = hash32(sid * 2654435761u + 12345u + mode * 977u);
    unsigned char* ws = a.ws; unsigned* slot = (unsigned*)(ws + WS_CTL + 32768) + mode;
    const float* MOD = (const float*)(ws + WS_MOD);
    if (mode == 0) {
        const int row = hs % NTOK, col = (hs >> 13) % DM; const float* xr = row < NPR ? FIN(IN_XP) + (size_t)row * DM : FIN(IN_XS) + (size_t)(row - NPR) * DM;
        float ss = 0.f; for (int k = 0; k < DM; ++k) ss += xr[k] * xr[k];
        const int cnd = row < NPR ? 4 : ((row - NPR) >> 10); const float* cv = cnd < 4 ? FIN(IN_C) + cnd * DM : FIN(IN_CCTX);
        float sh = FIN(IN_BMOD)[l * NMOD + col], sc = FIN(IN_BMOD)[l * NMOD + DM + col];
        for (int k = 0; k < DM; ++k) { const float v = cv[k], sv = v / (1.f + expf(-v)); sh += sv * FIN(IN_WMOD)[((size_t)l * DM + k) * NMOD + col]; sc += sv * FIN(IN_WMOD)[((size_t)l * DM + k) * NMOD + DM + col]; }
        const float ref = xr[col] * (1.f / sqrtf(ss / DM + EPS)) * FIN(IN_N1)[l * DM + col] * (1.f + sc) + sh;
        const float got = bf2f(((const bf16_t*)(ws + WS_H))[(size_t)row * DM + col]);
        dbg_report(slot, fabsf(got - ref) / (fabsf(ref) + 0.05f));
    } else if (mode == 1 || mode == 3) {
        const int row = hs % NTOK, col = (hs >> 13) % (mode == 1 ? 1024 : 4096); const bf16_t* hr = (const bf16_t*)(ws + WS_H) + (size_t)row * DM;
        const float* W = (mode == 1 ? FIN(IN_WIN) + (size_t)l * DM * 4096 + 2048 : FIN(IN_WGATE) + (size_t)l * DM * 4096) + col;
        float acc = 0.f, sa = 0.f; for (int k = 0; k < DM; ++k) { const float p = bf2f(hr[k]) * f2bf2f(W[(size_t)k * 4096]); acc += p; sa += fabsf(p); }
        float got, ref;
        if (mode == 1) { ref = acc; got = bf2f(((const bf16_t*)(ws + WS_V))[(size_t)row * 1024 + col]); }
        else { ref = 1.f / (1.f + expf(-acc)); h16x2 hh = __builtin_bit_cast(h16x2, (unsigned)((const unsigned short*)(ws + WS_G))[(size_t)row * 4096 + col]); got = (float)hh.x; }
        dbg_report(slot, fabsf(got - ref) / (mode == 1 ? (0.02f * sa + 1e-3f) : 1.0f));
    } else if (mode == 2) {
        const int row = hs % NTOK, head = (hs >> 13) % 16, d0 = (hs >> 17) % 64; const bf16_t* hr = (const bf16_t*)(ws + WS_H) + (size_t)row * DM;
        float ss = 0.f, mine = 0.f;
        for (int d = 0; d < 64; ++d) { const float* W = FIN(IN_WIN) + (size_t)l * DM * 4096 + head * 64 + d; float acc = 0.f; for (int k = 0; k < DM; ++k) acc += bf2f(hr[k]) * f2bf2f(W[(size_t)k * 4096]); ss += acc * acc; if (d == d0) mine = acc; }
        const float ref = mine * (1.f / sqrtf(ss / 64.f + EPS)) * FIN(IN_QG)[l * 64 + d0] * 0.125f;
        const float got = bf2f(((const bf16_t*)(ws + WS_Q))[(size_t)row * 1024 + head * 64 + d0]);
        dbg_report(slot, fabsf(got - ref) / 0.125f);
    } else if (mode == 4 || mode == 5) {
        const bf16_t* Qb = (const bf16_t*)(ws + WS_Q); const bf16_t* Kb = (const bf16_t*)(ws + WS_K); const bf16_t* Vb = (const bf16_t*)(ws + WS_V);
        const int h = (hs >> 13) % 16; int tok;
        if (mode == 4) tok = NPR + hs % 4096; else tok = hs % NPR;
        __shared__ float sq_[64 * 64], so_[64 * 64];
#define q(d) sq_[(d) * 64 + threadIdx.x]
#define o(d) so_[(d) * 64 + threadIdx.x]
        for (int d = 0; d < 64; ++d) q(d) = bf2f(Qb[(size_t)tok * 1024 + h * 64 + d]);
        float mx = -1e30f, lsum = 0.f; for (int d = 0; d < 64; ++d) o(d) = 0.f;
        for (int pass = 0; pass < 2; ++pass) {
            if (mode == 4) {
                const int b = (tok - NPR) >> 10, tt = (tok - NPR) & 1023, r = tt >> 6, qc = tt & 63, rs = iclamp(r - 4, 0, 8), wsq = iclamp(qc - 8, 0, 48);
#if !defined(MK_NATT_VARIANT) || MK_NATT_VARIANT != 1
                for (int i = 0; i < 8; ++i) for (int j = 0; j < 16; ++j) { const int kr = rs + i, kc = wsq + j, kt = NPR + b * 1024 + kr * 64 + kc;
                    float sc = 0.f; for (int d = 0; d < 64; ++d) sc += q(d) * bf2f(Kb[(size_t)kt * 1024 + h * 64 + d]);
                    sc += FIN(IN_RPB)[(size_t)(l * 16 + h) * 465 + (kr - r + 7) * 31 + iclamp(kc - qc + 15, 0, 30)];
                    if (pass == 0) mx = fmaxf(mx, sc); else { const float p = expf(sc - mx); lsum += p; for (int d = 0; d < 64; ++d) o(d) += p * bf2f(Vb[(size_t)kt * 1024 + h * 64 + d]); } }
#endif
#if !defined(MK_NATT_VARIANT) || MK_NATT_VARIANT != 2
                for (int j = 0; j < 256; ++j) { const size_t kt = (size_t)((b * 2 + l) * 256 + j);
                    float sc = 0.f; for (int d = 0; d < 64; ++d) sc += q(d) * FIN(IN_CK)[kt * 1024 + h * 64 + d];
                    if (pass == 0) mx = fmaxf(mx, sc); else { const float p = expf(sc - mx); lsum += p; for (int d = 0; d < 64; ++d) o(d) += p * FIN(IN_CV)[kt * 1024 + h * 64 + d]; } }
#endif
            } else {
                const int b = tok >> 8;
                for (int j = 0; j < 256; ++j) { const int kt = b * 256 + j;
                    float sc = 0.f; for (int d = 0; d < 64; ++d) sc += q(d) * bf2f(Kb[(size_t)kt * 1024 + h * 64 + d]);
                    if (pass == 0) mx = fmaxf(mx, sc); else { const float p = expf(sc - mx); lsum += p; for (int d = 0; d < 64; ++d) o(d) += p * bf2f(Vb[(size_t)kt * 1024 + h * 64 + d]); } }
            }
        }
        float rms = 0.f, err = 0.f; for (int d = 0; d < 64; ++d) { const float ref = o(d) / lsum; rms += ref * ref; err = fmaxf(err, fabsf(bf2f(((const bf16_t*)(ws + WS_ATT))[(size_t)tok * 1024 + h * 64 + d]) - ref)); }
        { const float e_ = err / (sqrtf(rms / 64.f) + 1e-3f); dbg_report(slot, e_);
          unsigned* cnt = (unsigned*)(ws + WS_CTL + 32768) + 16;
          if (e_ > 0.1f) { atomicAdd(cnt + (mode - 4), 1u);
            if (mode == 4) { const int tt = (tok - NPR) & 1023; atomicAdd(cnt + 4 + (tt >> 6), 1u); atomicAdd(cnt + 20 + ((tt & 63) >> 4), 1u); atomicAdd(cnt + 24 + h, 1u); } } }
#undef q
#undef o
    } else if (mode == 6) {
        const int tok = hs % NTOK, ch = (hs >> 13) % 1024, g = ch >> 8, m = ch & 255; int T, t; const bf16_t* ut;
        if (tok < NPR) { T = 256; t = tok & 255; ut = (const bf16_t*)(ws + WS_UTP) + (size_t)(tok >> 8) * 1024 * 1024; }
        else { T = 1024; t = (tok - NPR) & 1023; ut = (const bf16_t*)(ws + WS_UTS) + (size_t)((tok - NPR) >> 10) * 1024 * 1024; }
        float acc = 0.f, sa = 0.f;
        for (int c = 0; c < 256; ++c) { const bf16_t* ur = ut + (size_t)(g * 256 + rho256(c)) * 1024; const int pc = (m * c) & 255;
            for (int tp = 0; tp < T; ++tp) { const int pt = (t * tp) & (T - 1); const float x = 2.0f * ((float)pt / (float)T + (float)pc / 256.0f); const float v = bf2f(ur[tp]) * cospif(x); acc += v; sa += v * v; } }
        const float ref = acc / sqrtf((float)T * 256.f);
        const float got = bf2f(((const bf16_t*)(ws + WS_F))[(size_t)tok * 1024 + ch]);
        dbg_report(slot, fabsf(got - ref) / (sqrtf(sa / ((float)T * 256.f)) + 1e-3f));
    } else if (mode == 7) {
        const int row = hs % NTOK, col = (hs >> 13) % DM;
        const bf16_t* ar = (const bf16_t*)(ws + WS_ATT) + (size_t)row * 1024; const bf16_t* fr_ = (const bf16_t*)(ws + WS_F) + (size_t)row * 1024;
        float na = 0.f, fn = 0.f; for (int k = 0; k < 1024; ++k) { na += bf2f(ar[k]) * f2bf2f(FIN(IN_WNA)[((size_t)l * 1024 + k) * DM + col]); fn += bf2f(fr_[k]) * f2bf2f(FIN(IN_WFN)[((size_t)l * 1024 + k) * DM + col]); }
        const unsigned short* gr = (const unsigned short*)(ws + WS_G) + (size_t)row * 4096;
        h16x2 h1 = __builtin_bit_cast(h16x2, (unsigned)gr[col]), h2 = __builtin_bit_cast(h16x2, (unsigned)gr[2048 + col]);
        const float ref = (float)h1.x * na + (float)h2.x * fn;
        const float got = bf2f(((const bf16_t*)(ws + WS_MIX))[(size_t)row * DM + col]);
        dbg_report(slot, fabsf(got - ref) / (fabsf((float)h1.x * na) + fabsf((float)h2.x * fn) + 0.02f));
    } else if (mode == 8 || mode == 10) {
        const int row = hs % NTOK, col = (hs >> 13) % DM; const int cnd = row < NPR ? 4 : ((row - NPR) >> 10);
        float acc = 0.f, sa = 0.f; float base, gate, got;
        if (mode == 8) { const bf16_t* mr = (const bf16_t*)(ws + WS_MIX) + (size_t)row * DM; for (int k = 0; k < DM; ++k) { const float p = bf2f(mr[k]) * f2bf2f(FIN(IN_WO)[((size_t)l * DM + k) * DM + col]); acc += p; sa += fabsf(p); }
            base = row < NPR ? FIN(IN_XP)[(size_t)row * DM + col] : FIN(IN_XS)[(size_t)(row - NPR) * DM + col]; gate = MOD[(size_t)(l * 5 + cnd) * NMOD + 2 * DM + col]; got = ((const float*)(ws + WS_X1))[(size_t)row * DM + col]; }
        else { const bf16_t* mr = (const bf16_t*)(ws + WS_ACT) + (size_t)row * DFF; for (int k = 0; k < DFF; ++k) { const float p = bf2f(mr[k]) * f2bf2f(FIN(IN_WD)[((size_t)l * DFF + k) * DM + col]); acc += p; sa += fabsf(p); }
            base = ((const float*)(ws + WS_X1))[(size_t)row * DM + col]; gate = MOD[(size_t)(l * 5 + cnd) * NMOD + 5 * DM + col]; got = ((const float*)(ws + WS_X2))[(size_t)row * DM + col]; }
        const float ref = base + gate * acc;
        dbg_report(slot, fabsf(got - ref) / (0.02f * fabsf(gate) * sa + 1e-3f));
    } else if (mode == 9) {
        const int row = hs % NTOK, col = (hs >> 13) % DFF; const bf16_t* hr = (const bf16_t*)(ws + WS_H) + (size_t)row * DM;
        float aa = 0.f, gg = 0.f; for (int k = 0; k < DM; ++k) { const float hv = bf2f(hr[k]); aa += hv * f2bf2f(FIN(IN_WGU)[((size_t)l * DM + k) * 2 * DFF + col]); gg += hv * f2bf2f(FIN(IN_WGU)[((size_t)l * DM + k) * 2 * DFF + DFF + col]); }
        const float ref = aa * gg / (1.f + expf(-gg));
        const float got = bf2f(((const bf16_t*)(ws + WS_ACT))[(size_t)row * DFF + col]);
        dbg_report(slot, fabsf(got - ref) / (fabsf(ref) + 0.05f));
    }
}
__global__ void dbg_emit(Args a, int nmodes, float tol, int out_total) {
    const unsigned* slot = (const unsigned*)(a.ws + WS_CTL + 32768);
    for (int i = blockIdx.x * blockDim.x + threadIdx.x; i < out_total; i += gridDim.x * blockDim.x) a.out[i] = 0.f;
    __syncthreads();
    if (blockIdx.x == 0 && threadIdx.x == 0) {
#if defined(MK_DEBUG_COUNT)
        { unsigned c_ = slot[MK_DEBUG_COUNT] + 1u; int bk = 0; while (c_ > 1u) { c_ >>= 1; ++bk; } float V = 1e3f; for (int i = 0; i < bk; ++i) V *= 10.f; a.out[0] = V; }
#elif defined(MK_DEBUG_VALUE)
        a.out[0] = __uint_as_float(slot[MK_DEBUG_VALUE]) * 1e7f;
#else
        float V = 0.f; float dec = 1e3f;
        for (int m = 0; m < nmodes; ++m) { if (__uint_as_float(slot[m]) > tol && V == 0.f) V = dec; dec *= 10.f; }
        a.out[0] = V;
#endif
    }
}
#endif

extern "C" void kernel_launch(void* const* d_in, const int* in_sizes, int n_in, void* d_out, int out_size, void* d_ws, size_t ws_size, hipStream_t stream) {
    static int grid = 0;
    if (grid == 0) {
        if (n_in != 20 || ws_size < WS_END) { fprintf(stderr, "kernel_launch: unexpected n_in %d / ws_size %zu (need %zu)\n", n_in, ws_size, (size_t)WS_END); grid = -1; return; }
        int dev = 0, cus = 0, per_cu = 0;
        if (hipGetDevice(&dev) != hipSuccess || hipDeviceGetAttribute(&cus, hipDeviceAttributeMultiprocessorCount, dev) != hipSuccess) { grid = -1; return; }
        if (hipFuncSetAttribute((const void*)mk_fwd, hipFuncAttributeMaxDynamicSharedMemorySize, LDS_BYTES) != hipSuccess) { fprintf(stderr, "kernel_launch: hipFuncSetAttribute failed\n"); grid = -1; return; }
        if (hipOccupancyMaxActiveBlocksPerMultiprocessor(&per_cu, (const void*)mk_fwd, 512, LDS_BYTES) != hipSuccess || per_cu < 1) fprintf(stderr, "kernel_launch: occupancy query says %d\n", per_cu);
        (void)hipGetLastError();
        grid = cus;
        if (grid != 256) fprintf(stderr, "kernel_launch: %d CUs\n", grid);
    }
    if (grid < 0) return;
    (void)hipMemsetAsync((char*)d_ws + WS_CTL, 0, CTL_BYTES, stream);
    Args a{};
    for (int i = 0; i < 20; ++i) a.in[i] = (const float*)d_in[i];
    a.out = (float*)d_out; a.ws = (unsigned char*)d_ws;
#ifndef MK_PH_LIMIT
#define MK_PH_LIMIT N_PHASES
#endif
#if MK_LAUNCH_PER_PHASE
    for (int ph = 0; ph < MK_PH_LIMIT; ++ph) { a.ph_lo = ph; a.ph_hi = ph + 1; hipLaunchKernelGGL(mk_fwd, dim3(grid), dim3(512), LDS_BYTES, stream, a);
#if defined(MK_DEBUG_CHECK)
        { const int l = 0;
          if (ph == 1) hipLaunchKernelGGL(dbg_check, dim3(16), dim3(64), 0, stream, a, 0, l);
          if (ph == 2) { hipLaunchKernelGGL(dbg_check, dim3(64), dim3(64), 0, stream, a, 1, l); hipLaunchKernelGGL(dbg_check, dim3(16), dim3(64), 0, stream, a, 2, l); hipLaunchKernelGGL(dbg_check, dim3(64), dim3(64), 0, stream, a, 3, l); }
          if (ph == 3) { hipLaunchKernelGGL(dbg_check, dim3(64), dim3(64), 0, stream, a, 4, l); hipLaunchKernelGGL(dbg_check, dim3(64), dim3(64), 0, stream, a, 5, l); }
          if (ph == 4) hipLaunchKernelGGL(dbg_check, dim3(32), dim3(64), 0, stream, a, 6, l);
          if (ph == 5) hipLaunchKernelGGL(dbg_check, dim3(64), dim3(64), 0, stream, a, 7, l);
          if (ph == 6) hipLaunchKernelGGL(dbg_check, dim3(64), dim3(64), 0, stream, a, 8, l);
          if (ph == 8) hipLaunchKernelGGL(dbg_check, dim3(64), dim3(64), 0, stream, a, 9, l);
          if (ph == 9) hipLaunchKernelGGL(dbg_check, dim3(64), dim3(64), 0, stream, a, 10, l); }
#endif
    }
#if defined(MK_DEBUG_CHECK)
    hipLaunchKernelGGL(dbg_emit, dim3(256), dim3(256), 0, stream, a, 11, MK_DEBUG_TOL, out_size);
#endif
#else
    a.ph_lo = 0; a.ph_hi = N_PHASES;
    hipLaunchKernelGGL(mk_fwd, dim3(grid), dim3(512), LDS_BYTES, stream, a);
#endif
}
```

```cpp
#include <hip/hip_runtime.h>
#include <cstdio>
#include <cstdint>


#ifndef MK_LAUNCH_PER_PHASE
#define MK_LAUNCH_PER_PHASE 0
#endif

#define LAS __attribute__((address_space(3)))
typedef unsigned short bf16_t;
typedef short bf16x8 __attribute__((ext_vector_type(8)));
typedef short s16x4 __attribute__((ext_vector_type(4)));
typedef float f32x4 __attribute__((ext_vector_type(4)));
typedef unsigned u32x4 __attribute__((ext_vector_type(4)));
typedef unsigned u32x2 __attribute__((ext_vector_type(2)));
typedef _Float16 h16x2 __attribute__((ext_vector_type(2)));
typedef short v4i16_t __attribute__((ext_vector_type(4)));

constexpr int DM = 2048, NTOK = 8192, NPR = 4096, DFF = 5632, NMOD = 12288;
constexpr float EPS = 1e-6f, LOG2E = 1.4426950408889634f;
constexpr size_t OUT_NEWK = 8192ull * 2048, OUT_NEWV = OUT_NEWK + 16ull * 2 * 256 * 1024;

constexpr size_t MiB = 1u << 20;
constexpr size_t WS_CTL = 0, CTL_BYTES = 128 * 1024;
constexpr size_t WS_MOD = 1 * MiB;
constexpr size_t WS_DCT = 2 * MiB;
constexpr size_t WS_DT256 = 3 * MiB;
constexpr size_t WS_DT1024 = 4 * MiB;
constexpr size_t WS_CK = 8 * MiB, WS_CV = 12 * MiB;
constexpr size_t WS_W = 16 * MiB, W_LAYER = 114 * MiB;
constexpr size_t WO_W1 = 0, WO_NA = 32 * MiB, WO_FN = 36 * MiB, WO_O = 40 * MiB, WO_GU = 48 * MiB, WO_D = 92 * MiB;
constexpr size_t WS_H = 244 * MiB;
constexpr size_t WS_Q = 276 * MiB, WS_K = 292 * MiB, WS_V = 308 * MiB;
constexpr size_t WS_UTS = 324 * MiB;
constexpr size_t WS_UTP = 332 * MiB;
constexpr size_t WS_G = 364 * MiB;
constexpr size_t WS_ATT = 428 * MiB;
constexpr size_t WS_Y = 444 * MiB;
constexpr size_t WS_F = 476 * MiB;
constexpr size_t WS_MIX = 492 * MiB;
constexpr size_t WS_X1 = 524 * MiB;
constexpr size_t WS_ACT = 364 * MiB;
constexpr size_t WS_X2 = 588 * MiB;
constexpr size_t WS_PART = 652 * MiB;
constexpr size_t WS_END = 653 * MiB;

constexpr int RING_BYTES = 131072, LDSCTL_OFF = 143360, LDS_BYTES = 145408;

#define LDS_WAIT() asm volatile("s_waitcnt lgkmcnt(0)" ::: "memory")
#define VM_WAIT() asm volatile("s_waitcnt vmcnt(0)" ::: "memory")
typedef float f32x2_t __attribute__((ext_vector_type(2)));
typedef __bf16 bf16x2_t __attribute__((ext_vector_type(2)));
__device__ __forceinline__ unsigned cvt_pk_bf16(float lo, float hi) { f32x2_t v = {lo, hi}; bf16x2_t b = __builtin_convertvector(v, bf16x2_t); return __builtin_bit_cast(unsigned, b); }
__device__ __forceinline__ unsigned pk_h16(float lo, float hi) { h16x2 h; h.x = (_Float16)lo; h.y = (_Float16)hi; return __builtin_bit_cast(unsigned, h); }
__device__ __forceinline__ float h16_lo(unsigned u) { h16x2 h = __builtin_bit_cast(h16x2, u); return (float)h.x; }
__device__ __forceinline__ float h16_hi(unsigned u) { h16x2 h = __builtin_bit_cast(h16x2, u); return (float)h.y; }
__device__ __forceinline__ float fexp2(float x) { return __builtin_amdgcn_exp2f(x); }
__device__ __forceinline__ float frcp(float x) { return __builtin_amdgcn_rcpf(x); }
__device__ __forceinline__ float sigmoidf_(float x) { return frcp(1.0f + fexp2(-x * LOG2E)); }
#define GAS __attribute__((address_space(1)))
__device__ __forceinline__ f32x4 ldg_f4(const void* p) { return *(const GAS f32x4*)p; }
__device__ __forceinline__ u32x4 ldg_u4(const void* p) { return *(const GAS u32x4*)p; }
__device__ __forceinline__ void stg_f4(void* p, f32x4 v) { *(GAS f32x4*)p = v; }
__device__ __forceinline__ void stg_u4(void* p, u32x4 v) { *(GAS u32x4*)p = v; }
__device__ __forceinline__ void stg_u2(void* p, u32x2 v) { *(GAS u32x2*)p = v; }
__device__ __forceinline__ int iclamp(int v, int lo, int hi) { return v < lo ? lo : (v > hi ? hi : v); }
__device__ __forceinline__ int rho256(int L) { return 128 * ((L >> 5) & 1) + 32 * (L >> 6) + 16 * ((L >> 2) & 1) + 4 * ((L >> 3) & 3) + (L & 3); }
__device__ __forceinline__ int rho256_inv(int r) { const int bj = r >> 7, wc = (r >> 5) & 3, n = (r >> 4) & 1, fq = (r >> 2) & 3, j = r & 3; return 64 * wc + 32 * bj + 8 * fq + 4 * n + j; }

#define XB_TMO      128
#define XB_XCNT(j)  (256  + 64 * (j))
#define XB_XSUB(j)  (1280 + 64 * (j))
#define XB_XGEN(j)  (2304 + 64 * (j))
#define XB_TOP      3328
#define XB_TOPGEN   3392
#define XCD_BAR_WORDS 3456
#define XB_SPIN_CAP (1u << 20)
__device__ __forceinline__ unsigned xb_ld(unsigned* p)              { return __hip_atomic_load(p, __ATOMIC_RELAXED, __HIP_MEMORY_SCOPE_AGENT); }
__device__ __forceinline__ unsigned xb_add(unsigned* p, unsigned v) { return __hip_atomic_fetch_add(p, v, __ATOMIC_RELAXED, __HIP_MEMORY_SCOPE_AGENT); }
__device__ __forceinline__ unsigned xb_xcc_id() { return (unsigned)__builtin_amdgcn_s_getreg((3 << 11) | 20) & 0xFu; }
#define XB_SPIN(cond, bar) do { unsigned _sp = 0; while (cond) { __builtin_amdgcn_s_sleep(1); \
    if ((++_sp & 255u) == 0u) { if (xb_ld(&(bar)[XB_TMO])) break; if (_sp > XB_SPIN_CAP) { atomicAdd(&(bar)[XB_TMO], 1u); break; } } } } while (0)
struct XcdBarrier { unsigned* bar; unsigned x; volatile LAS unsigned* st; };
__device__ __forceinline__ XcdBarrier xcd_barrier_post(unsigned* bar, volatile LAS unsigned* st) {
    XcdBarrier b; b.bar = bar; b.x = xb_xcc_id(); b.st = st;
    if (threadIdx.x == 0) (void)xb_add(&bar[XB_XCNT(b.x)], 1u);
    return b;
}
__device__ __forceinline__ void xcd_barrier_complete(unsigned* bar, unsigned x, unsigned& nloc, unsigned& nx) {
    const unsigned G = gridDim.x * gridDim.y * gridDim.z;
    unsigned sum, cnt, mine, sp = 0u;
    for (;;) {
        sum = 0u; cnt = 0u; mine = 0u;
#pragma unroll
        for (unsigned j = 0; j < 16; ++j) { const unsigned c = xb_ld(&bar[XB_XCNT(j)]); sum += c; cnt += (c > 0u) ? 1u : 0u; mine = (j == x) ? c : mine; }
        if (sum == G) break;
        __builtin_amdgcn_s_sleep(1);
        if ((++sp & 255u) == 0u) { if (xb_ld(&bar[XB_TMO])) break; if (sp > XB_SPIN_CAP) { atomicAdd(&bar[XB_TMO], 1u); break; } }
    }
    nloc = mine > 0u ? mine : 1u; nx = cnt > 0u ? cnt : 1u;
}
__device__ __forceinline__ void xcd_barrier(const XcdBarrier& b) {
    asm volatile("s_waitcnt vmcnt(0)" ::: "memory");
    __syncthreads();
    if (threadIdx.x == 0) {
        unsigned* bar = b.bar;
        __builtin_amdgcn_s_waitcnt(0);
        unsigned nloc = b.st[0], nx = b.st[1];
        if (nloc == 0u) { xcd_barrier_complete(bar, b.x, nloc, nx); b.st[0] = nloc; b.st[1] = nx; }
        const unsigned old = xb_add(&bar[XB_XSUB(b.x)], 1u);
        const unsigned gen = old / nloc;
        if (old + 1u == (gen + 1u) * nloc) {
            __builtin_amdgcn_fence(__ATOMIC_RELEASE, "agent");
            asm volatile("s_waitcnt vmcnt(0)" ::: "memory");
            const unsigned og = xb_add(&bar[XB_TOP], 1u);
            const unsigned tg = og / nx;
            if (og + 1u == (tg + 1u) * nx) xb_add(&bar[XB_TOPGEN], 1u);
            else XB_SPIN(xb_ld(&bar[XB_TOPGEN]) == tg, bar);
            __builtin_amdgcn_fence(__ATOMIC_ACQUIRE, "agent");
            xb_add(&bar[XB_XGEN(b.x)], 1u);
            asm volatile("s_waitcnt vmcnt(0)" ::: "memory");
        } else {
            XB_SPIN(xb_ld(&bar[XB_XGEN(b.x)]) == gen, bar);
            __builtin_amdgcn_fence(__ATOMIC_ACQUIRE, "agent");
            asm volatile("s_waitcnt vmcnt(0)" ::: "memory");
        }
    }
    __syncthreads();
}

struct Args { const float* in[20]; float* out; unsigned char* ws; int ph_lo, ph_hi; };
typedef __attribute__((address_space(4))) const Args CArgs;
struct Frame {
    LAS unsigned char* lds;
    int wave, G, bid;
    float* out; unsigned char* ws;
};
#define FIN(i) (((CArgs*)__builtin_amdgcn_kernarg_segment_ptr())->in[i])
__device__ __forceinline__ int lane_id_volatile() { int l_; asm volatile("v_mbcnt_lo_u32_b32 %0, -1, 0\n\tv_mbcnt_hi_u32_b32 %0, -1, %0" : "=v"(l_)); return l_; }
#define FTID(F) ((F).wave * 64 + lane_id_volatile())
#define IN_XP 0
#define IN_XS 1
#define IN_CK 2
#define IN_CV 3
#define IN_C 4
#define IN_CCTX 5
#define IN_WMOD 6
#define IN_BMOD 7
#define IN_N1 8
#define IN_N2 9
#define IN_WIN 10
#define IN_QG 11
#define IN_KG 12
#define IN_RPB 13
#define IN_WNA 14
#define IN_WFN 15
#define IN_WGATE 16
#define IN_WO 17
#define IN_WGU 18
#define IN_WD 19

__device__ __forceinline__ int cond_of_pm(int pm) { return pm < 16 ? 4 : ((pm - 16) >> 2); }

constexpr int BM = 256, BK = 64, HALF = 128, HTB = HALF * BK * 2, NXCD = 8, WGM = 8;
__device__ __forceinline__ int lds_byte(int r, int c) { const int st = (r >> 4) * 2 + (c >> 5), rr = r & 15, cc = c & 31, ob = rr * 64 + cc * 2; return st * 1024 + (ob ^ (((ob >> 9) & 1) << 5)); }
__device__ __forceinline__ void stage_rc(int b, int& R, int& C) { const int st = b / 1024, sb = b % 1024, swz = sb ^ (((sb >> 9) & 1) << 5); R = (st >> 1) * 16 + swz / 64; C = (st & 1) * 32 + (swz % 64) / 2; }

#ifndef MK_SP2
#define MK_SP2 true
#endif
#ifndef MK_ALIGN
#define MK_ALIGN true
#endif
constexpr bool GEMM_SP2 = MK_SP2, GEMM_ALIGN_EPI = MK_ALIGN;
enum GemmType { GT_G1 = 0, GT_DFTPOS = 1, GT_DFTCH = 2, GT_G2 = 3, GT_G3 = 4, GT_G4 = 5, GT_G5 = 6, GT_G4M = 7 };
enum EpiKind { K_Q = 0, K_K, K_V, K_UT, K_G, K_Y, K_F, K_MIXA, K_MIXB, K_X1, K_ACT, K_X2 };
typedef const GAS char* gcptr;
struct Unit { gcptr A; gcptr B; int nt, kind, pm, pn, orow, ocol; };

__device__ __forceinline__ void tile_order(int L, int nM, int nN, int& pm, int& pn) {
    const int nwg = nM * nN; int wgid = L;
    { const int q = nwg / NXCD, r = nwg % NXCD, xcd = wgid % NXCD, off = wgid / NXCD; wgid = (xcd < r ? xcd * (q + 1) : r * (q + 1) + (xcd - r) * q) + off; }
    const int nig = WGM * nN, gid = wgid / nig, fm = gid * WGM, gsz = (nM - fm) < WGM ? (nM - fm) : WGM;
    pm = fm + ((wgid % nig) % gsz); pn = (wgid % nig) / gsz;
}

__device__ __forceinline__ bool get_unit(const Frame& F, int gt, int l, int i, int Geff, Unit& u) {
    size_t wso = 0; asm volatile("" : "+s"(wso));
    gcptr ws = (gcptr)F.ws + wso; const int G = Geff, c = F.bid;
    gcptr wl = ws + WS_W + (size_t)l * W_LAYER;
    u.orow = 0; u.ocol = 0;
    switch (gt) {
    case GT_G1: {
        const int L = i * G + c; if (L >= 32 * 32) return false;
        int pm, pn; tile_order(L, 32, 32, pm, pn); u.pm = pm; u.pn = pn; u.nt = 32;
        gcptr hrow = ws + WS_H + (size_t)pm * 256 * DM * 2; gcptr wrow = wl + WO_W1 + (size_t)pn * 256 * DM * 2;
        if (pn >= 12 && pn < 16) { u.A = wrow; u.B = hrow; u.kind = K_UT; u.ocol = (pn - 12) * 256; }
        else { u.A = hrow; u.B = wrow; u.kind = pn < 4 ? K_Q : (pn < 8 ? K_K : (pn < 12 ? K_V : K_G)); u.ocol = (pn < 4 ? pn : (pn < 8 ? pn - 4 : (pn < 12 ? pn - 8 : pn - 16))) * 256; }
        return true; }
    case GT_DFTPOS: {
        const int p = c + (i / 3) * G, sub = i % 3; if (p >= 128) return false;
        int b, mt, g, pm, T4;
        if (p < 64) { b = p >> 4; mt = (p >> 2) & 3; g = p & 3; pm = 16 + b * 4 + mt; T4 = 16; } else { b = (p - 64) >> 2; mt = 0; g = p & 3; pm = b; T4 = 4; }
        u.pm = pm; u.pn = g;
        if (sub < 2) { u.kind = K_Y; u.nt = T4; u.ocol = sub; u.orow = pm * 256;
            u.A = (p < 64) ? ws + WS_DT1024 + (size_t)(sub * 1024 + mt * 256) * 1024 * 2 : ws + WS_DT256 + (size_t)(sub * 256) * 1024 * 2;
            u.B = (p < 64) ? ws + WS_UTS + (size_t)(b * 1024 + g * 256) * 1024 * 2 : ws + WS_UTP + (size_t)(b * 1024 + g * 256) * 1024 * 2; }
        else { u.kind = K_F; u.nt = 8; u.orow = pm * 256; u.ocol = g * 256;
            u.A = ws + WS_Y + (((size_t)(g >> 1) * NTOK + pm * 256) * 1024 + (g & 1) * 512) * 2; u.B = ws + WS_DCT; }
        return true; }
    case GT_G2: {
        const int L = (i >> 1) * G + c; if (L >= 256) return false;
        int pm, pn; tile_order(L, 32, 8, pm, pn); u.pm = pm; u.pn = pn; u.nt = 16;
        if ((i & 1) == 0) { u.A = ws + WS_ATT + (size_t)pm * 256 * 1024 * 2; u.B = wl + WO_NA + (size_t)pn * 256 * 1024 * 2; u.kind = K_MIXA; }
        else { u.A = ws + WS_F + (size_t)pm * 256 * 1024 * 2; u.B = wl + WO_FN + (size_t)pn * 256 * 1024 * 2; u.kind = K_MIXB; }
        return true; }
    case GT_G3: {
        const int L = i * G + c; if (L >= 256) return false;
        int pm, pn; tile_order(L, 32, 8, pm, pn); u.pm = pm; u.pn = pn; u.nt = 32; u.kind = K_X1;
        u.A = ws + WS_MIX + (size_t)pm * 256 * DM * 2; u.B = wl + WO_O + (size_t)pn * 256 * DM * 2;
        return true; }
    case GT_G4: case GT_G4M: {
        const int L = i * G + c; if (L >= 32 * 44 || (gt == GT_G4M && i >= 5)) return false;
        int pm, pn; tile_order(L, 32, 44, pm, pn); u.pm = pm; u.pn = pn; u.nt = 32; u.kind = K_ACT;
        u.A = ws + WS_H + (size_t)pm * 256 * DM * 2; u.B = wl + WO_GU + (size_t)pn * 256 * DM * 2;
        return true; }
    default: {
        const int L = i * G + c; if (L >= 256) return false;
        int pm, pn; tile_order(L, 32, 8, pm, pn); u.pm = pm; u.pn = pn; u.nt = 88; u.kind = K_X2;
        u.A = ws + WS_ACT + (size_t)pm * 256 * DFF * 2; u.B = wl + WO_D + (size_t)pn * 256 * DFF * 2;
        return true; }
    }
}

__device__ __forceinline__ void epilogue(const f32x4 (&acc)[2][2][4][2], const Unit& u, const Frame& F, int l, int wr, int wc, int fr, int fq) {
    size_t wso = 0; asm volatile("" : "+s"(wso));
    unsigned char* ws = F.ws + wso;
    int rt0 = wr * 64 + fr;
    int c8 = wc * 64 + fq * 8;
    asm volatile("" : "+v"(rt0), "+v"(c8));
    switch (u.kind) {
    case K_Q: case K_K: {
        const bool isq = (u.kind == K_Q);
        const float* gam = (isq ? FIN(IN_QG) : FIN(IN_KG)) + l * 64; const float gs = isq ? 0.125f : 1.0f;
        f32x4 gv[2][2];
#pragma unroll
        for (int bj = 0; bj < 2; ++bj)
#pragma unroll
            for (int n = 0; n < 2; ++n) gv[bj][n] = ldg_f4(gam + 32 * bj + 8 * fq + 4 * n) * gs;
        bf16_t* dst = (bf16_t*)(ws + (isq ? WS_Q : WS_K)) + (size_t)(u.pm * 256 + rt0) * 1024 + u.ocol + c8;
        float* dk = F.out + OUT_NEWK + ((size_t)(u.pm * 2 + l) * 256 + rt0) * 1024 + u.ocol + c8;
        const bool wk = (!isq) && (u.pm < 16);
#pragma unroll
        for (int ai = 0; ai < 2; ++ai)
#pragma unroll
            for (int m = 0; m < 4; ++m) {
                float ss = 0.f;
#pragma unroll
                for (int bj = 0; bj < 2; ++bj)
#pragma unroll
                    for (int n = 0; n < 2; ++n) { const f32x4 v = acc[ai][bj][m][n]; ss += (v[0] * v[0] + v[1] * v[1]) + (v[2] * v[2] + v[3] * v[3]); }
                ss += __shfl_xor(ss, 16); ss += __shfl_xor(ss, 32);
                const float rs = __builtin_amdgcn_rsqf(ss * (1.0f / 64.0f) + EPS);
                const size_t ro = (size_t)(ai * 128 + m * 16) * 1024;
#pragma unroll
                for (int bj = 0; bj < 2; ++bj) {
                    const f32x4 o0 = acc[ai][bj][m][0] * rs * gv[bj][0], o1 = acc[ai][bj][m][1] * rs * gv[bj][1];
                    u32x4 w; w.x = cvt_pk_bf16(o0[0], o0[1]); w.y = cvt_pk_bf16(o0[2], o0[3]); w.z = cvt_pk_bf16(o1[0], o1[1]); w.w = cvt_pk_bf16(o1[2], o1[3]);
                    stg_u4(dst + ro + 32 * bj, w);
                    if (wk) { stg_f4(dk + ro + 32 * bj, o0); stg_f4(dk + ro + 32 * bj + 4, o1); }
                }
            }
        break; }
    case K_V: {
        bf16_t* dst = (bf16_t*)(ws + WS_V) + (size_t)(u.pm * 256 + rt0) * 1024 + u.ocol + c8;
        float* dv = F.out + OUT_NEWV + ((size_t)(u.pm * 2 + l) * 256 + rt0) * 1024 + u.ocol + c8;
        const bool wv = (u.pm < 16);
#pragma unroll
        for (int ai = 0; ai < 2; ++ai)
#pragma unroll
            for (int m = 0; m < 4; ++m) { const size_t ro = (size_t)(ai * 128 + m * 16) * 1024;
#pragma unroll
                for (int bj = 0; bj < 2; ++bj) { const f32x4 o0 = acc[ai][bj][m][0], o1 = acc[ai][bj][m][1];
                    u32x4 w; w.x = cvt_pk_bf16(o0[0], o0[1]); w.y = cvt_pk_bf16(o0[2], o0[3]); w.z = cvt_pk_bf16(o1[0], o1[1]); w.w = cvt_pk_bf16(o1[2], o1[3]);
                    stg_u4(dst + ro + 32 * bj, w);
                    if (wv) { stg_f4(dv + ro + 32 * bj, o0); stg_f4(dv + ro + 32 * bj + 4, o1); } } }
        break; }
    case K_UT: {
        const int pm = u.pm; bf16_t* base;
        if (pm >= 16) base = (bf16_t*)(ws + WS_UTS) + ((size_t)((pm - 16) >> 2) * 1024 + u.ocol) * 1024 + ((pm - 16) & 3) * 256;
        else base = (bf16_t*)(ws + WS_UTP) + ((size_t)pm * 1024 + u.ocol) * 1024;
        base += (size_t)rt0 * 1024 + wc * 32 + fq * 4;
#pragma unroll
        for (int ai = 0; ai < 2; ++ai)
#pragma unroll
            for (int m = 0; m < 4; ++m) { bf16_t* rp = base + (size_t)(ai * 128 + m * 16) * 1024;
#pragma unroll
                for (int bj = 0; bj < 2; ++bj)
#pragma unroll
                    for (int n = 0; n < 2; ++n) { const f32x4 v = acc[ai][bj][m][n]; u32x2 w; w.x = cvt_pk_bf16(v[0], v[1]); w.y = cvt_pk_bf16(v[2], v[3]); stg_u2(rp + 128 * bj + 16 * n, w); } }
        break; }
    case K_G: {
        unsigned short* dst = (unsigned short*)(ws + WS_G) + (size_t)(u.pm * 256 + rt0) * 4096 + u.ocol + c8;
#pragma unroll
        for (int ai = 0; ai < 2; ++ai)
#pragma unroll
            for (int m = 0; m < 4; ++m) { const size_t ro = (size_t)(ai * 128 + m * 16) * 4096;
#pragma unroll
                for (int bj = 0; bj < 2; ++bj) { const f32x4 o0 = acc[ai][bj][m][0], o1 = acc[ai][bj][m][1];
                    u32x4 w; w.x = pk_h16(sigmoidf_(o0[0]), sigmoidf_(o0[1])); w.y = pk_h16(sigmoidf_(o0[2]), sigmoidf_(o0[3])); w.z = pk_h16(sigmoidf_(o1[0]), sigmoidf_(o1[1])); w.w = pk_h16(sigmoidf_(o1[2]), sigmoidf_(o1[3]));
                    stg_u4(dst + ro + 32 * bj, w); } }
        break; }
    case K_Y: case K_F: {
        const bool isy = (u.kind == K_Y);
        bf16_t* dst = isy ? (bf16_t*)(ws + WS_Y) + ((size_t)(u.pn >> 1) * NTOK + u.orow + rt0) * 1024 + (u.pn & 1) * 512 + u.ocol * 256 + c8
                          : (bf16_t*)(ws + WS_F) + (size_t)(u.orow + rt0) * 1024 + u.ocol + c8;
#pragma unroll
        for (int ai = 0; ai < 2; ++ai)
#pragma unroll
            for (int m = 0; m < 4; ++m) { const size_t ro = (size_t)(ai * 128 + m * 16) * 1024;
#pragma unroll
                for (int bj = 0; bj < 2; ++bj) { const f32x4 o0 = acc[ai][bj][m][0], o1 = acc[ai][bj][m][1];
                    u32x4 w; w.x = cvt_pk_bf16(o0[0], o0[1]); w.y = cvt_pk_bf16(o0[2], o0[3]); w.z = cvt_pk_bf16(o1[0], o1[1]); w.w = cvt_pk_bf16(o1[2], o1[3]);
                    stg_u4(dst + ro + 32 * bj, w); } }
        if (isy) asm volatile("s_waitcnt vmcnt(0)" ::: "memory");
        break; }
    case K_MIXA: case K_MIXB: {
        const unsigned short* gb = (const unsigned short*)(ws + WS_G) + (size_t)(u.pm * 256 + rt0) * 4096 + u.pn * 256 + c8 + 2048;
        bf16_t* dst = (bf16_t*)(ws + WS_MIX) + (size_t)(u.pm * 256 + rt0) * DM + u.pn * 256 + c8;
        u32x4 gg[2][2];
#define MIXB_LOAD(slot, g) do { const size_t rg_ = (size_t)(((g) >> 2) * 128 + ((g) & 3) * 16) * 4096; _Pragma("unroll") for (int bj = 0; bj < 2; ++bj) gg[slot][bj] = ldg_u4(gb + rg_ + 32 * bj); } while (0)
        MIXB_LOAD(0, 0);
#pragma unroll
        for (int g = 0; g < 8; ++g) { const int ai = g >> 2, m = g & 3, sl = g & 1; const size_t ro = (size_t)(ai * 128 + m * 16) * DM;
            if (g < 7) MIXB_LOAD((g + 1) & 1, g + 1);
#pragma unroll
            for (int bj = 0; bj < 2; ++bj) {
                const u32x4 q = gg[sl][bj];
                const f32x4 g0 = (f32x4){fmaxf(h16_lo(q.x), 1e-30f), fmaxf(h16_hi(q.x), 1e-30f), fmaxf(h16_lo(q.y), 1e-30f), fmaxf(h16_hi(q.y), 1e-30f)}, g1 = (f32x4){fmaxf(h16_lo(q.z), 1e-30f), fmaxf(h16_hi(q.z), 1e-30f), fmaxf(h16_lo(q.w), 1e-30f), fmaxf(h16_hi(q.w), 1e-30f)};
                const f32x4 o0 = acc[ai][bj][m][0] * g0, o1 = acc[ai][bj][m][1] * g1;
                u32x4 w; w.x = cvt_pk_bf16(o0[0], o0[1]); w.y = cvt_pk_bf16(o0[2], o0[3]); w.z = cvt_pk_bf16(o1[0], o1[1]); w.w = cvt_pk_bf16(o1[2], o1[3]);
                stg_u4(dst + ro + 32 * bj, w); } }
#undef MIXB_LOAD
        break; }
    case K_X1: case K_X2: {
        const bool is1 = (u.kind == K_X1);
        const int cond = cond_of_pm(u.pm);
        const float* gate = (const float*)(ws + WS_MOD) + (size_t)(l * 5 + cond) * NMOD + (is1 ? 2 : 5) * DM + u.pn * 256 + c8;
        f32x4 gv[2][2];
#pragma unroll
        for (int bj = 0; bj < 2; ++bj)
#pragma unroll
            for (int n = 0; n < 2; ++n) gv[bj][n] = ldg_f4(gate + 32 * bj + 4 * n);
        const size_t eo = (size_t)(u.pm * 256 + rt0) * DM + u.pn * 256 + c8;
        const float* src; float* dst;
        if (is1) { src = (l == 0) ? (u.pm < 16 ? FIN(IN_XP) : FIN(IN_XS) - (size_t)NPR * DM) : (const float*)(ws + WS_X2); dst = (float*)(ws + WS_X1); }
        else { src = (const float*)(ws + WS_X1); dst = (l == 0) ? (float*)(ws + WS_X2) : F.out; }
        src += eo; dst += eo;
        f32x4 xr[2][4];
#define XRES_LOAD(slot, g) do { const size_t ro_ = (size_t)(((g) >> 2) * 128 + ((g) & 3) * 16) * DM; \
            _Pragma("unroll") for (int bj = 0; bj < 2; ++bj) { xr[slot][2 * bj] = ldg_f4(src + ro_ + 32 * bj); xr[slot][2 * bj + 1] = ldg_f4(src + ro_ + 32 * bj + 4); } } while (0)
        XRES_LOAD(0, 0);
#pragma unroll
        for (int g = 0; g < 8; ++g) { const int ai = g >> 2, m = g & 3, sl = g & 1; const size_t ro = (size_t)(ai * 128 + m * 16) * DM;
            if (g < 7) XRES_LOAD((g + 1) & 1, g + 1);
#pragma unroll
            for (int bj = 0; bj < 2; ++bj)
#pragma unroll
                for (int n = 0; n < 2; ++n) stg_f4(dst + ro + 32 * bj + 4 * n, xr[sl][2 * bj + n] + gv[bj][n] * acc[ai][bj][m][n]); }
#undef XRES_LOAD
        break; }
    default: {
        bf16_t* dst = (bf16_t*)(ws + WS_ACT) + (size_t)(u.pm * 256 + rt0) * DFF + u.pn * 128 + wc * 32 + fq * 8;
#pragma unroll
        for (int ai = 0; ai < 2; ++ai)
#pragma unroll
            for (int m = 0; m < 4; ++m) { float o[8];
#pragma unroll
                for (int e = 0; e < 8; ++e) { const float a = acc[ai][0][m][e >> 2][e & 3], g = acc[ai][1][m][e >> 2][e & 3]; o[e] = a * g * sigmoidf_(g); }
                u32x4 w; w.x = cvt_pk_bf16(o[0], o[1]); w.y = cvt_pk_bf16(o[2], o[3]); w.z = cvt_pk_bf16(o[4], o[5]); w.w = cvt_pk_bf16(o[6], o[7]);
                stg_u4(dst + (size_t)(ai * 128 + m * 16) * DFF, w); }
        break; }
    }
}


__device__ __forceinline__ void mixa_scale(f32x4 (&acc)[2][2][4][2], const Unit& u, const Frame& F, int wr, int wc, int fr, int fq) {
    size_t wso = 0; asm volatile("" : "+s"(wso)); unsigned char* ws = F.ws + wso;
    int rt0 = wr * 64 + fr, c8 = wc * 64 + fq * 8; asm volatile("" : "+v"(rt0), "+v"(c8));
    const unsigned short* gb = (const unsigned short*)(ws + WS_G) + (size_t)(u.pm * 256 + rt0) * 4096 + u.pn * 256 + c8;
#pragma unroll
    for (int g = 0; g < 8; ++g) { const int ai = g >> 2, m = g & 3; const size_t rg = (size_t)(ai * 128 + m * 16) * 4096;
#pragma unroll
        for (int bj = 0; bj < 2; ++bj) { const u32x4 a = ldg_u4(gb + rg + 32 * bj), f = ldg_u4(gb + rg + 2048 + 32 * bj);
            const float an[8] = {h16_lo(a.x), h16_hi(a.x), h16_lo(a.y), h16_hi(a.y), h16_lo(a.z), h16_hi(a.z), h16_lo(a.w), h16_hi(a.w)};
            const float fn_[8] = {h16_lo(f.x), h16_hi(f.x), h16_lo(f.y), h16_hi(f.y), h16_lo(f.z), h16_hi(f.z), h16_lo(f.w), h16_hi(f.w)};
#pragma unroll
            for (int e = 0; e < 8; ++e) acc[ai][bj][m][e >> 2][e & 3] *= an[e] * frcp(fmaxf(fn_[e], 1e-30f)); } }
}

__device__ __forceinline__ void fused_resnorm_epilogue(f32x4 (&acc)[2][2][4][2], const Unit& u, const Frame& F, int l, bool is1) {
    unsigned char* ws = F.ws;
    int tid = FTID(F); asm volatile("" : "+v"(tid));
    const int lane = tid & 63, fr = lane & 15, fq = lane >> 4, wr = F.wave >> 2, wc = F.wave & 3;
    const int rt0 = wr * 64 + fr, c8 = wc * 64 + fq * 8, cond = cond_of_pm(u.pm), use = is1 ? 2 * l : 2 * l + 1;
    const size_t tile_el = (size_t)u.pm * 256 * DM + u.pn * 256;
    const unsigned lo4 = (unsigned)(rt0 * DM + c8) * 4u, lo2 = (unsigned)(rt0 * DM + c8) * 2u;
    const char* srcb; char* dstb;
    if (is1) { srcb = (const char*)((l == 0) ? (u.pm < 16 ? FIN(IN_XP) : FIN(IN_XS) - (size_t)NPR * DM) : (const float*)(ws + WS_X2)); dstb = (char*)(ws + WS_X1); }
    else { srcb = (const char*)(ws + WS_X1); dstb = (char*)(ws + WS_X2); }
    srcb += tile_el * 4; dstb += tile_el * 4;
    const float* gate = (const float*)(ws + WS_MOD) + (size_t)(l * 5 + cond) * NMOD + (is1 ? 2 : 5) * DM + u.pn * 256 + c8;
#define GRP_OFF(g, elsz) ((size_t)((((g) >> 2) * 128 + ((g) & 3) * 16) * DM) * (elsz))
    float ssq[8];
#pragma unroll
    for (int g = 0; g < 8; ++g) ssq[g] = 0.f;
#pragma unroll
    for (int bj = 0; bj < 2; ++bj) {
        f32x4 xr[2][2], gv[2];
        gv[0] = ldg_f4(gate + 32 * bj); gv[1] = ldg_f4(gate + 32 * bj + 4);
        xr[0][0] = ldg_f4(srcb + (lo4 + 128u * bj)); xr[0][1] = ldg_f4(srcb + (lo4 + 128u * bj + 16u));
#pragma unroll
        for (int g = 0; g < 8; ++g) { const int ai = g >> 2, m = g & 3, sl = g & 1;
            if (g < 7) { xr[sl ^ 1][0] = ldg_f4(srcb + GRP_OFF(g + 1, 4) + (lo4 + 128u * bj)); xr[sl ^ 1][1] = ldg_f4(srcb + GRP_OFF(g + 1, 4) + (lo4 + 128u * bj + 16u)); }
#pragma unroll
            for (int n = 0; n < 2; ++n) { const f32x4 xn = xr[sl][n] + gv[n] * acc[ai][bj][m][n]; stg_f4(dstb + GRP_OFF(g, 4) + (lo4 + 128u * bj + 16u * n), xn); acc[ai][bj][m][n] = xn;
                ssq[g] += (xn[0] * xn[0] + xn[1] * xn[1]) + (xn[2] * xn[2] + xn[3] * xn[3]); }
            asm volatile("" ::: "memory"); }
    }
    { float* part = (float*)(ws + WS_PART) + ((size_t)u.pm * 256 + rt0) * 32 + u.pn * 4 + wc;
#pragma unroll
      for (int g = 0; g < 8; ++g) { float ss = ssq[g]; ss += __shfl_xor(ss, 16); ss += __shfl_xor(ss, 32);
          __hip_atomic_store(part + (size_t)((g >> 2) * 128 + (g & 3) * 16) * 32, ss, __ATOMIC_RELAXED, __HIP_MEMORY_SCOPE_AGENT); } }
    asm volatile("s_waitcnt vmcnt(0)" ::: "memory");
    unsigned* cnt = (unsigned*)(ws + WS_CTL + 65536) + (size_t)(use * 32 + u.pm) * 64;
    if (lane == 0) __hip_atomic_fetch_add(cnt, 1u, __ATOMIC_RELAXED, __HIP_MEMORY_SCOPE_AGENT);
    if (F.wave == 0) { unsigned sp = 0u;
        while ((unsigned)__builtin_amdgcn_readfirstlane(__hip_atomic_load(cnt, __ATOMIC_RELAXED, __HIP_MEMORY_SCOPE_AGENT)) < 64u) { __builtin_amdgcn_s_sleep(2); if (++sp > (1u << 19)) break; }
        __builtin_amdgcn_fence(__ATOMIC_ACQUIRE, "agent");
        asm volatile("s_waitcnt vmcnt(0)" ::: "memory"); }
    asm volatile("s_waitcnt vmcnt(0) lgkmcnt(0)" ::: "memory"); __builtin_amdgcn_s_barrier(); asm volatile("" ::: "memory");
    LAS float* S = (LAS float*)(F.lds);
    { const int row = F.wave * 32 + (lane & 31), half = lane >> 5; const float* pr = (const float*)(ws + WS_PART) + ((size_t)u.pm * 256 + row) * 32 + half * 16;
      float t = 0.f;
#pragma unroll
      for (int k = 0; k < 8; ++k) { const unsigned long long v2 = __hip_atomic_load((const unsigned long long*)pr + k, __ATOMIC_RELAXED, __HIP_MEMORY_SCOPE_AGENT);
          t += __uint_as_float((unsigned)v2) + __uint_as_float((unsigned)(v2 >> 32)); }
      t += __shfl_xor(t, 32);
      if (half == 0) S[row] = __builtin_amdgcn_rsqf(t * (1.0f / DM) + EPS); }
    asm volatile("s_waitcnt lgkmcnt(0)" ::: "memory"); __builtin_amdgcn_s_barrier(); asm volatile("" ::: "memory");
    const int ln = is1 ? l : l + 1;
    const float* gam = (is1 ? FIN(IN_N2) : FIN(IN_N1)) + ln * DM + u.pn * 256 + c8;
    const float* modp = (const float*)(ws + WS_MOD) + (size_t)(ln * 5 + cond) * NMOD + (is1 ? 3 : 0) * DM + u.pn * 256 + c8;
    char* hdb = (char*)(ws + WS_H) + tile_el * 2;
    float rs8[8];
#pragma unroll
    for (int g = 0; g < 8; ++g) rs8[g] = S[(g >> 2) * 128 + wr * 64 + (g & 3) * 16 + fr];
#pragma unroll
    for (int bj = 0; bj < 2; ++bj) {
        f32x4 mul[2], add[2];
#pragma unroll
        for (int n = 0; n < 2; ++n) { mul[n] = ldg_f4(gam + 32 * bj + 4 * n) * (ldg_f4(modp + DM + 32 * bj + 4 * n) + 1.0f); add[n] = ldg_f4(modp + 32 * bj + 4 * n); }
#pragma unroll
        for (int g = 0; g < 8; ++g) { const int ai = g >> 2, m = g & 3;
            const f32x4 o0 = acc[ai][bj][m][0] * rs8[g] * mul[0] + add[0], o1 = acc[ai][bj][m][1] * rs8[g] * mul[1] + add[1];
            u32x4 w; w.x = cvt_pk_bf16(o0[0], o0[1]); w.y = cvt_pk_bf16(o0[2], o0[3]); w.z = cvt_pk_bf16(o1[0], o1[1]); w.w = cvt_pk_bf16(o1[2], o1[3]);
            stg_u4(hdb + GRP_OFF(g, 2) + (lo2 + 64u * bj), w); }
    }
#undef GRP_OFF
}

__device__ __forceinline__ void gemm_phase(const Frame& F, int gt, int l, int Geff) {
    LAS unsigned char* lds = F.lds;
    int tid = FTID(F); asm volatile("" : "+v"(tid));
    const int wid = F.wave, lane = tid & 63, wr = wid >> 2, wc = wid & 3, fr = lane & 15, fq = lane >> 4;
    int lda, ldb;
    switch (gt) { case GT_G1: case GT_G3: case GT_G4: case GT_G4M: lda = 2048; ldb = 2048; break; case GT_DFTPOS: case GT_G2: lda = 1024; ldb = 1024; break; default: lda = DFF; ldb = DFF; break; }
    unsigned voffA[2], voffB[2];
#pragma unroll
    for (int i = 0; i < 2; ++i) { int R, C; stage_rc(tid * 16 + i * 8192, R, C); voffA[i] = (unsigned)(R * lda + C) * 2u; voffB[i] = (unsigned)(R * ldb + C) * 2u; }
    const size_t kstep = (size_t)(BK * 2);
    const size_t hstepA = (size_t)HALF * lda * 2, hstepB = (size_t)HALF * ldb * 2;
    const unsigned ldsw = (unsigned)wid * 1024u;
    const int aoff = lds_byte(wr * 64 + fr, fq * 8), boff = lds_byte(wc * 32 + fr, fq * 8);
#define PG8_SA(b, h) (((b) * 2 + (h)) * HTB)
#define PG8_SB(b, h) ((4 + (b) * 2 + (h)) * HTB)
#define PG8_STAGE(bufoff, gbase, voff) do { _Pragma("unroll") for (int _i = 0; _i < 2; ++_i) \
        __builtin_amdgcn_global_load_lds((const GAS unsigned*)((gbase) + (voff)[_i]), (LAS unsigned*)(lds + (bufoff) + ldsw + _i * 8192), 16, 0, 0); } while (0)
#define PG8_LDA(dst, b, h) do { _Pragma("unroll") for (int m = 0; m < 4; ++m) _Pragma("unroll") for (int k = 0; k < 2; ++k) dst[m][k] = *(const LAS bf16x8*)(lds + PG8_SA(b, h) + aoff + m * 2048 + k * 1024); } while (0)
#define PG8_LDB(dst, b, h) do { _Pragma("unroll") for (int n = 0; n < 2; ++n) _Pragma("unroll") for (int k = 0; k < 2; ++k) dst[n][k] = *(const LAS bf16x8*)(lds + PG8_SB(b, h) + boff + n * 2048 + k * 1024); } while (0)
#define PG8_MMA(ai, bj, At, Bt) do { __builtin_amdgcn_s_setprio(1); _Pragma("unroll") for (int m = 0; m < 4; ++m) _Pragma("unroll") for (int n = 0; n < 2; ++n) _Pragma("unroll") for (int k = 0; k < 2; ++k) \
        acc[ai][bj][m][n] = __builtin_amdgcn_mfma_f32_16x16x32_bf16(Bt[n][k], At[m][k], acc[ai][bj][m][n], 0, 0, 0); __builtin_amdgcn_s_setprio(0); } while (0)
#define PG8_WAIT_V(n) asm volatile("s_waitcnt vmcnt(" #n ")" ::: "memory")
#define PG8_WAIT_L(n) asm volatile("s_waitcnt lgkmcnt(" #n ")" ::: "memory")
#define PG8_BAR __builtin_amdgcn_s_barrier()
#define PG8_SCHED __builtin_amdgcn_sched_barrier(0)
    Unit cur, nxt; int ui = 0;
    int g256 = F.G; asm volatile("" : "+s"(g256));
    const bool fused = (g256 == 256) && (gt == GT_G3 || (gt == GT_G5 && l == 0));
    if (!get_unit(F, gt, l, 0, Geff, cur)) return;
    f32x4 acc[2][2][4][2];
#pragma unroll
    for (int a = 0; a < 2; ++a)
#pragma unroll
        for (int b = 0; b < 2; ++b)
#pragma unroll
            for (int m = 0; m < 4; ++m)
#pragma unroll
                for (int n = 0; n < 2; ++n) acc[a][b][m][n] = (f32x4){0.f, 0.f, 0.f, 0.f};
    bf16x8 At[4][2], B0[2][2], B1[2][2];
    gcptr cA = cur.A; gcptr cB = cur.B;
    if constexpr (GEMM_SP2) {
        PG8_STAGE(PG8_SB(0, 0), cB, voffB); PG8_STAGE(PG8_SB(0, 1), cB + hstepB, voffB); PG8_STAGE(PG8_SA(0, 0), cA, voffA); PG8_STAGE(PG8_SA(0, 1), cA + hstepA, voffA);
        if (wr == 1) PG8_BAR;
        PG8_WAIT_V(2); PG8_BAR;
        PG8_STAGE(PG8_SB(1, 0), cB + kstep, voffB); PG8_STAGE(PG8_SA(1, 0), cA + kstep, voffA); PG8_STAGE(PG8_SB(1, 1), cB + hstepB + kstep, voffB);
        PG8_WAIT_V(6); PG8_BAR;
    } else {
    PG8_STAGE(PG8_SB(0, 0), cB, voffB); PG8_STAGE(PG8_SA(0, 0), cA, voffA); PG8_STAGE(PG8_SB(0, 1), cB + hstepB, voffB); PG8_STAGE(PG8_SA(0, 1), cA + hstepA, voffA);
    if (wr == 1) PG8_BAR;
    PG8_WAIT_V(4); PG8_BAR;
    PG8_STAGE(PG8_SB(1, 0), cB + kstep, voffB); PG8_STAGE(PG8_SA(1, 0), cA + kstep, voffA); PG8_STAGE(PG8_SB(1, 1), cB + hstepB + kstep, voffB);
    PG8_WAIT_V(6); PG8_BAR;
    }
    for (;;) {
        const bool has_next = get_unit(F, gt, l, ui + 1, Geff, nxt);
        gcptr nA = has_next ? nxt.A : cA; gcptr nB = has_next ? nxt.B : cB;
        const int nt = cur.nt;
        for (int t = 0; t < nt; t += 2) {
            const bool last = (t == nt - 2);
            gcptr a1 = cA + (size_t)(t + 1) * kstep;
            gcptr a2 = last ? nA : cA + (size_t)(t + 2) * kstep; gcptr b2 = last ? nB : cB + (size_t)(t + 2) * kstep;
            gcptr a3 = a2 + kstep; gcptr b3 = b2 + kstep;
            if constexpr (GEMM_SP2) {
            PG8_LDB(B0, 0, 0); PG8_LDB(B1, 0, 1); PG8_SCHED; PG8_LDA(At, 0, 0); PG8_STAGE(PG8_SA(1, 1), a1 + hstepA, voffA);
            PG8_WAIT_V(8); PG8_WAIT_L(0); PG8_BAR; PG8_MMA(0, 0, At, B0); PG8_MMA(0, 1, At, B1); PG8_BAR; PG8_SCHED;
            PG8_LDA(At, 0, 1); PG8_STAGE(PG8_SB(0, 0), b2, voffB); PG8_STAGE(PG8_SB(0, 1), b2 + hstepB, voffB); PG8_STAGE(PG8_SA(0, 0), a2, voffA);
            PG8_WAIT_V(8); PG8_WAIT_L(0); PG8_BAR; PG8_MMA(1, 0, At, B0); PG8_MMA(1, 1, At, B1); PG8_BAR; PG8_SCHED;
            PG8_LDB(B0, 1, 0); PG8_LDB(B1, 1, 1); PG8_SCHED; PG8_LDA(At, 1, 0); PG8_STAGE(PG8_SA(0, 1), a2 + hstepA, voffA);
            PG8_WAIT_V(8); PG8_WAIT_L(0); PG8_BAR; PG8_MMA(0, 0, At, B0); PG8_MMA(0, 1, At, B1); PG8_BAR; PG8_SCHED;
            PG8_LDA(At, 1, 1); PG8_STAGE(PG8_SB(1, 0), b3, voffB); PG8_STAGE(PG8_SB(1, 1), b3 + hstepB, voffB); PG8_STAGE(PG8_SA(1, 0), a3, voffA);
            PG8_WAIT_V(8); PG8_WAIT_L(0); PG8_BAR; PG8_MMA(1, 0, At, B0); PG8_MMA(1, 1, At, B1); PG8_BAR; PG8_SCHED;
            } else {
            PG8_LDB(B0, 0, 0); PG8_SCHED; PG8_LDA(At, 0, 0); PG8_STAGE(PG8_SA(1, 1), a1 + hstepA, voffA);
            PG8_WAIT_L(8); PG8_BAR; PG8_WAIT_L(0); PG8_MMA(0, 0, At, B0); PG8_BAR; PG8_SCHED;
            PG8_LDB(B1, 0, 1); PG8_STAGE(PG8_SB(0, 0), b2, voffB);
            PG8_BAR; PG8_WAIT_L(0); PG8_MMA(0, 1, At, B1); PG8_BAR;
            PG8_LDA(At, 0, 1); PG8_STAGE(PG8_SA(0, 0), a2, voffA);
            PG8_BAR; PG8_WAIT_L(0); PG8_MMA(1, 0, At, B0); PG8_BAR; PG8_SCHED;
            PG8_STAGE(PG8_SB(0, 1), b2 + hstepB, voffB);
            PG8_WAIT_V(6); PG8_BAR; PG8_MMA(1, 1, At, B1); PG8_BAR;
            PG8_LDB(B0, 1, 0); PG8_SCHED; PG8_LDA(At, 1, 0); PG8_STAGE(PG8_SA(0, 1), a2 + hstepA, voffA);
            PG8_WAIT_L(8); PG8_BAR; PG8_WAIT_L(0); PG8_MMA(0, 0, At, B0); PG8_BAR; PG8_SCHED;
            PG8_LDB(B1, 1, 1); PG8_STAGE(PG8_SB(1, 0), b3, voffB);
            PG8_BAR; PG8_WAIT_L(0); PG8_MMA(0, 1, At, B1); PG8_BAR;
            PG8_LDA(At, 1, 1); PG8_STAGE(PG8_SA(1, 0), a3, voffA);
            PG8_BAR; PG8_WAIT_L(0); PG8_MMA(1, 0, At, B0); PG8_BAR; PG8_SCHED;
            PG8_STAGE(PG8_SB(1, 1), b3 + hstepB, voffB);
            PG8_WAIT_V(6); PG8_BAR; PG8_MMA(1, 1, At, B1); PG8_BAR;
            }
        }
        if constexpr (GEMM_ALIGN_EPI) { if (wr == 0) PG8_BAR; }
        if (cur.kind == K_MIXA) mixa_scale(acc, cur, F, wr, wc, fr, fq);
        else if (!fused) epilogue(acc, cur, F, l, wr, wc, fr, fq);
        if (!has_next) break;
        if (cur.kind != K_MIXA) {
#pragma unroll
            for (int a = 0; a < 2; ++a)
#pragma unroll
                for (int b = 0; b < 2; ++b)
#pragma unroll
                    for (int m = 0; m < 4; ++m)
#pragma unroll
                        for (int n = 0; n < 2; ++n) acc[a][b][m][n] = (f32x4){0.f, 0.f, 0.f, 0.f};
        }
        cur = nxt; cA = nA; cB = nB; ++ui;
        if constexpr (GEMM_ALIGN_EPI) { if (wr == 1) PG8_BAR; }
    }
    PG8_WAIT_V(0);
    if constexpr (!GEMM_ALIGN_EPI) { if (wr == 0) PG8_BAR; }
    PG8_BAR;
    if (fused) fused_resnorm_epilogue(acc, cur, F, l, gt == GT_G3);
}

__device__ __forceinline__ void gemm_half_g4(const Frame& F, int l) {
    LAS unsigned char* lds = F.lds;
    int tid = FTID(F); asm volatile("" : "+v"(tid));
    const int wid = F.wave, lane = tid & 63, wr = wid >> 2, wc = wid & 3, fr = lane & 15, fq = lane >> 4;
    constexpr int lda = 2048, ldb = 2048, nt = 32;
    unsigned voffA[2], voffB[2];
#pragma unroll
    for (int i = 0; i < 2; ++i) { int R, C; stage_rc(tid * 16 + i * 8192, R, C); voffA[i] = (unsigned)(R * lda + C) * 2u; voffB[i] = (unsigned)(R * ldb + C) * 2u; }
    const size_t kstep = (size_t)(BK * 2), hstepB = (size_t)HALF * ldb * 2;
    const unsigned ldsw = (unsigned)wid * 1024u;
    const int aoff = lds_byte(wr * 64 + fr, fq * 8), boff = lds_byte(wc * 32 + fr, fq * 8);
    const int c = F.bid, hA = c & 1; int pm, pn; tile_order(1280 + (c >> 1), 32, 44, pm, pn);
    gcptr cA = (gcptr)F.ws + WS_H + (size_t)(pm * 256 + hA * 128) * DM * 2; gcptr cB = (gcptr)F.ws + WS_W + (size_t)l * W_LAYER + WO_GU + (size_t)pn * 256 * DM * 2;
    f32x4 acc[1][2][4][2];
#pragma unroll
    for (int b = 0; b < 2; ++b)
#pragma unroll
        for (int m = 0; m < 4; ++m)
#pragma unroll
            for (int n = 0; n < 2; ++n) acc[0][b][m][n] = (f32x4){0.f, 0.f, 0.f, 0.f};
    bf16x8 At[4][2], B0[2][2], B1[2][2];
    PG8_STAGE(PG8_SB(0, 0), cB, voffB); PG8_STAGE(PG8_SA(0, 0), cA, voffA); PG8_STAGE(PG8_SB(0, 1), cB + hstepB, voffB);
    if (wr == 1) PG8_BAR;
    PG8_WAIT_V(2); PG8_BAR;
    PG8_STAGE(PG8_SB(1, 0), cB + kstep, voffB); PG8_STAGE(PG8_SA(1, 0), cA + kstep, voffA);
    PG8_WAIT_V(6); PG8_BAR;
    for (int t = 0; t < nt; t += 2) {
        const int t2 = (t + 2 < nt) ? t + 2 : nt - 1, t3 = (t + 3 < nt) ? t + 3 : nt - 1;
        gcptr b1 = cB + (size_t)(t + 1) * kstep; gcptr a2 = cA + (size_t)t2 * kstep; gcptr b2 = cB + (size_t)t2 * kstep; gcptr a3 = cA + (size_t)t3 * kstep; gcptr b3 = cB + (size_t)t3 * kstep;
        PG8_LDB(B0, 0, 0); PG8_SCHED; PG8_LDA(At, 0, 0); PG8_STAGE(PG8_SB(1, 1), b1 + hstepB, voffB);
        PG8_WAIT_V(6); PG8_WAIT_L(0); PG8_BAR; PG8_MMA(0, 0, At, B0); PG8_BAR; PG8_SCHED;
        PG8_LDB(B1, 0, 1); PG8_STAGE(PG8_SB(0, 0), b2, voffB); PG8_STAGE(PG8_SA(0, 0), a2, voffA);
        PG8_WAIT_V(6); PG8_WAIT_L(0); PG8_BAR; PG8_MMA(0, 1, At, B1); PG8_BAR; PG8_SCHED;
        PG8_LDB(B0, 1, 0); PG8_SCHED; PG8_LDA(At, 1, 0); PG8_STAGE(PG8_SB(0, 1), b2 + hstepB, voffB);
        PG8_WAIT_V(6); PG8_WAIT_L(0); PG8_BAR; PG8_MMA(0, 0, At, B0); PG8_BAR; PG8_SCHED;
        PG8_LDB(B1, 1, 1); PG8_STAGE(PG8_SB(1, 0), b3, voffB); PG8_STAGE(PG8_SA(1, 0), a3, voffA);
        PG8_WAIT_V(6); PG8_WAIT_L(0); PG8_BAR; PG8_MMA(0, 1, At, B1); PG8_BAR; PG8_SCHED;
    }
    if (wr == 0) PG8_BAR;
    {
        int rt0 = wr * 64 + fr; asm volatile("" : "+v"(rt0));
        bf16_t* dst = (bf16_t*)(F.ws + WS_ACT) + (size_t)(pm * 256 + hA * 128 + rt0) * DFF + pn * 128 + wc * 32 + fq * 8;
#pragma unroll
        for (int m = 0; m < 4; ++m) { float o[8];
#pragma unroll
            for (int e = 0; e < 8; ++e) { const float a = acc[0][0][m][e >> 2][e & 3], g = acc[0][1][m][e >> 2][e & 3]; o[e] = a * g * sigmoidf_(g); }
            u32x4 w; w.x = cvt_pk_bf16(o[0], o[1]); w.y = cvt_pk_bf16(o[2], o[3]); w.z = cvt_pk_bf16(o[4], o[5]); w.w = cvt_pk_bf16(o[6], o[7]);
            stg_u4(dst + (size_t)(m * 16) * DFF, w); }
    }
    PG8_WAIT_V(0);
    PG8_BAR;
}
#undef PG8_SA
#undef PG8_SB
#undef PG8_STAGE
#undef PG8_LDA
#undef PG8_LDB
#undef PG8_MMA
#undef PG8_WAIT_V
#undef PG8_WAIT_L
#undef PG8_BAR
#undef PG8_SCHED

__device__ __forceinline__ int dst_row_std(int nn) { return (nn & ~255) + rho256(nn & 255); }
__device__ __forceinline__ int dst_row_glu(int nn) { const int half = nn >= DFF ? 1 : 0, cc = nn - half * DFF, pn = cc >> 7, L = cc & 127;
    return pn * 256 + 128 * half + 32 * (L >> 5) + 16 * ((L >> 2) & 1) + 4 * ((L >> 3) & 3) + (L & 3); }
constexpr int TR_SCR_BYTES = 64 * 65 * 4;
constexpr int I_IN = (DM / 64) * (4096 / 64), I_NA = (1024 / 64) * (DM / 64), I_O = (DM / 64) * (DM / 64), I_GU = (DM / 64) * (2 * DFF / 64), I_D = (DFF / 64) * (DM / 64);
constexpr int I_LAYER = 2 * I_IN + 2 * I_NA + I_O + I_GU + I_D, I_EARLY = 2 * I_IN;
struct TItem { const float* W; bf16_t* WT; int K, N, mode, row_off, k0, n0; };
__device__ __forceinline__ TItem titem_decode(const Frame& F, int it) {
    TItem t; unsigned char* ws = F.ws; const int l = it / I_LAYER; int r = it % I_LAYER; unsigned char* wl = ws + WS_W + (size_t)l * W_LAYER;
    t.mode = 0; t.row_off = 0;
    if (r < I_IN) { t.W = FIN(IN_WIN) + (size_t)l * DM * 4096; t.K = DM; t.N = 4096; t.WT = (bf16_t*)(wl + WO_W1); }
    else if ((r -= I_IN) < I_IN) { t.W = FIN(IN_WGATE) + (size_t)l * DM * 4096; t.K = DM; t.N = 4096; t.WT = (bf16_t*)(wl + WO_W1); t.row_off = 4096; }
    else if ((r -= I_IN) < I_NA) { t.W = FIN(IN_WNA) + (size_t)l * 1024 * DM; t.K = 1024; t.N = DM; t.WT = (bf16_t*)(wl + WO_NA); }
    else if ((r -= I_NA) < I_NA) { t.W = FIN(IN_WFN) + (size_t)l * 1024 * DM; t.K = 1024; t.N = DM; t.WT = (bf16_t*)(wl + WO_FN); }
    else if ((r -= I_NA) < I_O) { t.W = FIN(IN_WO) + (size_t)l * DM * DM; t.K = DM; t.N = DM; t.WT = (bf16_t*)(wl + WO_O); }
    else if ((r -= I_O) < I_GU) { t.W = FIN(IN_WGU) + (size_t)l * DM * 2 * DFF; t.K = DM; t.N = 2 * DFF; t.WT = (bf16_t*)(wl + WO_GU); t.mode = 1; }
    else { r -= I_GU; t.W = FIN(IN_WD) + (size_t)l * DFF * DM; t.K = DFF; t.N = DM; t.WT = (bf16_t*)(wl + WO_D); }
    const int nblk = t.N / 64; t.k0 = 64 * (r / nblk); t.n0 = 64 * (r % nblk);
    return t;
}
__device__ __forceinline__ void titem_load(const TItem& t, int lane, f32x4 (&wv)[16]) {
    const float* wp = t.W + (size_t)(t.k0 + (lane >> 4)) * t.N + t.n0 + 4 * (lane & 15);
#pragma unroll
    for (int i = 0; i < 16; ++i) wv[i] = *(const f32x4*)(wp + (size_t)(4 * i) * t.N);
}
__device__ __forceinline__ void titem_finish(const TItem& t, int lane, const f32x4 (&wv)[16], LAS float* scr) {
    const int rr = lane >> 4, c4 = lane & 15;
#pragma unroll
    for (int i = 0; i < 16; ++i) { LAS float* d = scr + (4 * i + rr) * 65 + 4 * c4; d[0] = wv[i][0]; d[1] = wv[i][1]; d[2] = wv[i][2]; d[3] = wv[i][3]; }
    LDS_WAIT();
    const int c = lane & 7;
#pragma unroll
    for (int j = 0; j < 8; ++j) { const int n = (lane >> 3) + 8 * j; const LAS float* sp = scr + (8 * c) * 65 + n;
        u32x4 o; o.x = cvt_pk_bf16(sp[0 * 65], sp[1 * 65]); o.y = cvt_pk_bf16(sp[2 * 65], sp[3 * 65]); o.z = cvt_pk_bf16(sp[4 * 65], sp[5 * 65]); o.w = cvt_pk_bf16(sp[6 * 65], sp[7 * 65]);
        const int dr = t.row_off + (t.mode ? dst_row_glu(t.n0 + n) : dst_row_std(t.n0 + n));
        *(u32x4*)(t.WT + (size_t)dr * t.K + t.k0 + 8 * c) = o; }
    LDS_WAIT();
}
__device__ __forceinline__ void convert_range(const Frame& F, int lo, int hi, int gwv, int nwv) {
    int lane_ = FTID(F); asm volatile("" : "+v"(lane_)); lane_ &= 63;
    LAS float* scr = (LAS float*)(F.lds + F.wave * TR_SCR_BYTES);
    for (int it = lo + gwv; it < hi; it += 2 * nwv) {
        const int itb = it + nwv; const bool hb = itb < hi;
        const TItem a = titem_decode(F, it), b = titem_decode(F, hb ? itb : it);
        f32x4 va[16], vb[16];
        titem_load(a, lane_, va); titem_load(b, lane_, vb);
        titem_finish(a, lane_, va, scr);
        if (hb) titem_finish(b, lane_, vb, scr);
    }
}

__device__ __forceinline__ void p0_phase(const Frame& F) {
    unsigned char* ws = F.ws;
    int tid_ = FTID(F); asm volatile("" : "+v"(tid_)); const int lane_ = tid_ & 63;
    for (int item = F.bid; item < 256; item += F.G) {
        const int l = item >> 7, col0 = (item & 127) * 96;
        LAS float* S = (LAS float*)F.lds;
        LAS float* R = (LAS float*)(F.lds + 40960);
        for (int idx = tid_; idx < 5 * DM; idx += 512) { const int cnd = idx >> 11, k = idx & 2047; const float v = cnd < 4 ? FIN(IN_C)[cnd * DM + k] : FIN(IN_CCTX)[k]; S[idx] = v * sigmoidf_(v); }
        __syncthreads();
        const int sub = lane_ / 24, lc = lane_ - sub * 24, rsel = sub >= 1 ? 1 : 0;
        f32x4 a[5];
#pragma unroll
        for (int cnd = 0; cnd < 5; ++cnd) a[cnd] = (f32x4){0.f, 0.f, 0.f, 0.f};
        const float* wp = FIN(IN_WMOD) + ((size_t)l * DM + F.wave * 256 + rsel) * NMOD + col0 + 4 * lc;
        LAS const float* Sw = S + F.wave * 256 + rsel;
        for (int kk = 0; kk < 256; kk += 16) {
            f32x4 wv[8];
#pragma unroll
            for (int j = 0; j < 8; ++j) wv[j] = *(const f32x4*)(wp + (size_t)(kk + 2 * j) * NMOD);
#pragma unroll
            for (int j = 0; j < 8; ++j) {
#pragma unroll
                for (int cnd = 0; cnd < 5; ++cnd) { const float sv = Sw[cnd * DM + kk + 2 * j]; a[cnd] += wv[j] * sv; } }
        }
        if (sub < 2) {
#pragma unroll
            for (int cnd = 0; cnd < 5; ++cnd) *(LAS f32x4*)(R + ((F.wave * 2 + rsel) * 5 + cnd) * 96 + 4 * lc) = a[cnd]; }
        __syncthreads();
        for (int idx = tid_; idx < 5 * 96; idx += 512) { const int cnd = idx / 96, col = idx - cnd * 96; float sacc = FIN(IN_BMOD)[l * NMOD + col0 + col];
#pragma unroll
            for (int p = 0; p < 16; ++p) sacc += R[(p * 5 + cnd) * 96 + col];
            __hip_atomic_store((float*)(ws + WS_MOD) + (size_t)(l * 5 + cnd) * NMOD + col0 + col, sacc, __ATOMIC_RELAXED, __HIP_MEMORY_SCOPE_AGENT); }
        __syncthreads();
    }
    asm volatile("s_waitcnt vmcnt(0)" ::: "memory");
    __syncthreads();
    if (tid_ == 0) { unsigned nmine = 0; for (int item = F.bid; item < 43; item += F.G) ++nmine;
        if (nmine) (void)__hip_atomic_fetch_add((unsigned*)(ws + WS_CTL + 110592), nmine, __ATOMIC_RELAXED, __HIP_MEMORY_SCOPE_AGENT); }
    const int gw = F.bid * 8 + F.wave, NGW = F.G * 8;
    constexpr int C_CACHE = 4 * 2 * 256 * 1024 / 512, C_DT1024 = 2 * 1024 * 1024 / 512, C_DT256 = 2 * 256 * 256 / 512, C_DCT = 256 * 512 / 512;
    for (int ch = gw; ch < 2 * C_CACHE + C_DT1024 + C_DT256 + C_DCT; ch += NGW) {
        int r = ch; float v[8]; bf16_t* dst;
        if (r < 2 * C_CACHE) { const int which = r / C_CACHE; const size_t e = (size_t)(r % C_CACHE) * 512 + lane_ * 8; const float* src = (which ? FIN(IN_CV) : FIN(IN_CK)) + e;
            const f32x4 x0 = *(const f32x4*)src, x1 = *(const f32x4*)(src + 4); v[0] = x0[0]; v[1] = x0[1]; v[2] = x0[2]; v[3] = x0[3]; v[4] = x1[0]; v[5] = x1[1]; v[6] = x1[2]; v[7] = x1[3];
            dst = (bf16_t*)(ws + (which ? WS_CV : WS_CK)) + e; }
        else { r -= 2 * C_CACHE;
            if (r < C_DT1024) { const int e = r * 512 + lane_ * 8, cs = e >> 20, t = (e >> 10) & 1023, t0 = e & 1023;
#pragma unroll
                for (int j = 0; j < 8; ++j) { const int mm = (t * (t0 + j)) & 1023; const float x = (float)mm * (2.0f / 1024.0f); v[j] = (cs ? sinpif(x) : cospif(x)) * (1.0f / 32.0f); }
                dst = (bf16_t*)(ws + WS_DT1024) + e; }
            else { r -= C_DT1024;
                if (r < C_DT256) { const int e = r * 512 + lane_ * 8, cs = e >> 16, t = (e >> 8) & 255, t0 = e & 255;
#pragma unroll
                    for (int j = 0; j < 8; ++j) { const int mm = (t * (t0 + j)) & 255; const float x = (float)mm * (2.0f / 256.0f); v[j] = (cs ? sinpif(x) : cospif(x)) * (1.0f / 16.0f); }
                    dst = (bf16_t*)(ws + WS_DT256) + ((size_t)(cs * 256 + t) * 1024 + t0); }
                else { r -= C_DT256; const int e = r * 512 + lane_ * 8, row = e >> 9, col = e & 511, mlog = rho256_inv(row);
#pragma unroll
                    for (int j = 0; j < 8; ++j) { const int cc = col + j, cch = cc & 255, mm = (mlog * cch) & 255; const float x = (float)mm * (2.0f / 256.0f); v[j] = (cc < 256 ? cospif(x) : -sinpif(x)) * (1.0f / 16.0f); }
                    dst = (bf16_t*)(ws + WS_DCT) + (size_t)row * 1024 + col; } } }
        u32x4 o; o.x = cvt_pk_bf16(v[0], v[1]); o.y = cvt_pk_bf16(v[2], v[3]); o.z = cvt_pk_bf16(v[4], v[5]); o.w = cvt_pk_bf16(v[6], v[7]);
        *(u32x4*)dst = o;
    }
}

__device__ __forceinline__ float wave_sum(float v) {
#pragma unroll
    for (int o = 1; o < 64; o <<= 1) v += __shfl_xor(v, o);
    return v;
}
__device__ __forceinline__ void norm_phase(const Frame& F, int l, int which) {
    unsigned char* ws = F.ws;
    int lane = FTID(F); asm volatile("" : "+v"(lane)); lane &= 63;
    const int gw = F.bid * 8 + F.wave, NGW = F.G * 8;
    const float* gam = (which ? FIN(IN_N2) : FIN(IN_N1)) + l * DM;
    for (int row0 = gw; row0 < NTOK; row0 += 2 * NGW) {
        f32x4 v[2][8]; float ss[2] = {0.f, 0.f}; const int row1 = row0 + NGW;
#pragma unroll
        for (int r = 0; r < 2; ++r) { const int row = r ? row1 : row0; if (row < NTOK) {
            const float* xr;
            if (which) xr = (const float*)(ws + WS_X1) + (size_t)row * DM;
            else if (l == 0) xr = row < NPR ? FIN(IN_XP) + (size_t)row * DM : FIN(IN_XS) + (size_t)(row - NPR) * DM;
            else xr = (const float*)(ws + WS_X2) + (size_t)row * DM;
#pragma unroll
            for (int j = 0; j < 8; ++j) v[r][j] = *(const f32x4*)(xr + 256 * j + 4 * lane); } }
#pragma unroll
        for (int r = 0; r < 2; ++r) { const int row = r ? row1 : row0; if (row < NTOK) {
#pragma unroll
            for (int j = 0; j < 8; ++j) ss[r] += (v[r][j][0] * v[r][j][0] + v[r][j][1] * v[r][j][1]) + (v[r][j][2] * v[r][j][2] + v[r][j][3] * v[r][j][3]);
            const float rstd = __builtin_amdgcn_rsqf(wave_sum(ss[r]) * (1.0f / DM) + EPS);
            const int cond = row < NPR ? 4 : ((row - NPR) >> 10);
            const float* mod = (const float*)(ws + WS_MOD) + (size_t)(l * 5 + cond) * NMOD + (which ? 3 : 0) * DM;
            bf16_t* orow = (bf16_t*)(ws + WS_H) + (size_t)row * DM;
#pragma unroll
            for (int j = 0; j < 8; ++j) { const int c0 = 256 * j + 4 * lane;
                const f32x4 g = *(const f32x4*)(gam + c0), sh = *(const f32x4*)(mod + c0), sc = *(const f32x4*)(mod + DM + c0);
                const f32x4 o = v[r][j] * rstd * g * (sc + 1.0f) + sh;
                u32x2 w; w.x = cvt_pk_bf16(o[0], o[1]); w.y = cvt_pk_bf16(o[2], o[3]); *(u32x2*)(orow + c0) = w; } } }
    }
}

__device__ __forceinline__ unsigned vswz(int row, int byte) { return (unsigned)(row * 128 + ((((byte >> 4) ^ (((row >> 1) & 3) << 1)) << 4) | (byte & 15))); }
__device__ __forceinline__ s16x4 vtr(LAS const unsigned char* p) { return __builtin_bit_cast(s16x4, __builtin_amdgcn_ds_read_tr16_b64_v4i16((LAS v4i16_t*)p)); }

struct AttnState { float m, lsum; f32x4 o[4]; };

template <bool LOCAL, bool KLDS>
__device__ __forceinline__ void attn_chunk(AttnState& st, const bf16x8 (&qf)[2], const bf16_t* kp, const unsigned (&klds)[2], LAS const unsigned char* vbase, int vrow0, const unsigned (&voff)[4],
                                           LAS const float* rpbL, int qc, int wsq, int cs, int drbase, int fq) {
    f32x4 s[16];
#define KOFF(kb) (LOCAL ? ((size_t)(((kb) >> 1) * 64 + ((kb) & 1) * 16) * 1024) : ((size_t)(kb) * 16 * 1024))
#define VROW(kb) (LOCAL ? (vrow0 + ((kb) >> 1) * 64 + ((kb) & 1) * 16) : (vrow0 + (kb) * 16))
    {
        bf16x8 kf[16][2];
#pragma unroll
        for (int kb = 0; kb < 16; ++kb) {
            if (KLDS) { kf[kb][0] = *(LAS const bf16x8*)(vbase + klds[0] + kb * 2048); kf[kb][1] = *(LAS const bf16x8*)(vbase + klds[1] + kb * 2048); }
            else { const bf16_t* p = kp + KOFF(kb); kf[kb][0] = *(const bf16x8*)p; kf[kb][1] = *(const bf16x8*)(p + 32); } }
#pragma unroll
        for (int kb = 0; kb < 16; ++kb) { f32x4 z = (f32x4){0.f, 0.f, 0.f, 0.f};
            z = __builtin_amdgcn_mfma_f32_16x16x32_bf16(kf[kb][0], qf[0], z, 0, 0, 0);
            s[kb] = __builtin_amdgcn_mfma_f32_16x16x32_bf16(kf[kb][1], qf[1], z, 0, 0, 0); }
    }
    asm volatile("" ::: "memory");
    if (LOCAL) {
#pragma unroll
        for (int kb = 0; kb < 16; ++kb) {
            const int dr = drbase + (kb >> 1);
#pragma unroll
            for (int r = 0; r < 4; ++r) { const int kc = cs + 16 * (kb & 1) + 4 * fq + r; const int dc = iclamp(kc - qc + 15, 0, 30);
                float b = rpbL[dr * 31 + dc]; asm volatile("" : "+v"(b));
                const bool ok = (unsigned)(kc - wsq) < 16u;
                s[kb][r] = ok ? s[kb][r] + b : -__builtin_inff(); }
        }
    }
    float mx = -__builtin_inff();
#pragma unroll
    for (int kb = 0; kb < 16; ++kb) mx = fmaxf(fmaxf(mx, fmaxf(s[kb][0], s[kb][1])), fmaxf(s[kb][2], s[kb][3]));
    mx = fmaxf(mx, __shfl_xor(mx, 16)); mx = fmaxf(mx, __shfl_xor(mx, 32));
    const float mnew = fmaxf(st.m, mx);
    const float alpha = fexp2((st.m - mnew) * LOG2E);
    st.m = mnew; st.lsum *= alpha;
#pragma unroll
    for (int d = 0; d < 4; ++d) st.o[d] = st.o[d] * alpha;
    const float mb = mnew * LOG2E;
    float ps = 0.f;
#pragma unroll
    for (int ks = 0; ks < 8; ++ks) {
        float p[8];
#pragma unroll
        for (int r = 0; r < 4; ++r) { p[r] = fexp2(s[2 * ks][r] * LOG2E - mb); p[4 + r] = fexp2(s[2 * ks + 1][r] * LOG2E - mb); }
        ps += ((p[0] + p[1]) + (p[2] + p[3])) + ((p[4] + p[5]) + (p[6] + p[7]));
        u32x4 pw; pw.x = cvt_pk_bf16(p[0], p[1]); pw.y = cvt_pk_bf16(p[2], p[3]); pw.z = cvt_pk_bf16(p[4], p[5]); pw.w = cvt_pk_bf16(p[6], p[7]);
        const bf16x8 pf = __builtin_bit_cast(bf16x8, pw);
        LAS const unsigned char* v0 = vbase + VROW(2 * ks) * 128; LAS const unsigned char* v1 = vbase + VROW(2 * ks + 1) * 128;
#pragma unroll
        for (int d = 0; d < 4; ++d) { const s16x4 a0 = vtr(v0 + voff[d]), a1 = vtr(v1 + voff[d]);
            bf16x8 af; af[0] = a0[0]; af[1] = a0[1]; af[2] = a0[2]; af[3] = a0[3]; af[4] = a1[0]; af[5] = a1[1]; af[6] = a1[2]; af[7] = a1[3];
            st.o[d] = __builtin_amdgcn_mfma_f32_16x16x32_bf16(af, pf, st.o[d], 0, 0, 0); }
        if (ks & 1) asm volatile("" ::: "memory");
    }
    st.lsum += ps;
#undef KOFF
#undef VROW
}

__device__ __forceinline__ void attn_phase(const Frame& F, int l) {
    unsigned char* ws = F.ws; LAS unsigned char* lds = F.lds;
    const int w = F.wave;
    const bf16_t* Qb = (const bf16_t*)(ws + WS_Q); const bf16_t* Kb = (const bf16_t*)(ws + WS_K); const bf16_t* Vb = (const bf16_t*)(ws + WS_V);
    bf16_t* Ob = (bf16_t*)(ws + WS_ATT);
    constexpr int VCTX_ROW0 = 576, KCTX_OFF = (576 + 256) * 128, RPB_OFF = KCTX_OFF + 32768;
    const int qx = F.bid & 7;
    unsigned* qctr = (unsigned*)(ws + WS_CTL + 98304) + (l * 8 + qx) * 64;
    volatile LAS int* QN = (volatile LAS int*)(lds + LDSCTL_OFF + 256);
    if (FTID(F) == 0) QN[0] = (int)__hip_atomic_fetch_add(qctr, 1u, __ATOMIC_RELAXED, __HIP_MEMORY_SCOPE_AGENT);
    __syncthreads();
    int qe = QN[0];
    while (qe < 128) {
        int nxt_ = 0;
        const int item = qe < 64 ? 64 * qx + qe : 512 + 64 * qx + (qe - 64);
        __syncthreads();
        int tid = FTID(F); asm volatile("" : "+v"(tid));
        if (tid == 0) nxt_ = (int)__hip_atomic_fetch_add(qctr, 1u, __ATOMIC_RELAXED, __HIP_MEMORY_SCOPE_AGENT);
        const int lane = tid & 63, i16 = lane & 15, fq = lane >> 4;
        unsigned voff[4];
        { const int qp = i16 >> 2, p = i16 & 3; const int sw = ((2 * fq + (qp >> 1)) & 3) << 1;
#pragma unroll
          for (int d = 0; d < 4; ++d) voff[d] = (unsigned)((4 * fq + qp) * 128 + ((8 * p) & 15) + ((p >> 1) << 4) + (((2 * d) ^ sw) << 4)); }
        unsigned klds[2];
#pragma unroll
        for (int sx = 0; sx < 2; ++sx) klds[sx] = (unsigned)(KCTX_OFF + i16 * 128 + (((4 * sx + fq) ^ (i16 & 7)) << 4));
        if (item < 512) {
            const int b = item >> 7, h = (item >> 3) & 15, rp = item & 7;
            const int rs2 = iclamp(2 * rp - 4, 0, 8); const int nrows = (rs2 + 9 > 16 ? 16 - rs2 : 9) * 64;
            const int tokb = NPR + b * 1024;
            {
                const int r0 = tid >> 3, ch = tid & 7; u32x4 xl[9], xc[4], xk[4];
                const bf16_t* ksrc = (const bf16_t*)(ws + WS_CK) + (size_t)((b * 2 + l) * 256 + r0) * 1024 + h * 64 + ch * 8;
                const bf16_t* vsrc = Vb + (size_t)(tokb + rs2 * 64 + r0) * 1024 + h * 64 + ch * 8;
                const bf16_t* csrc = (const bf16_t*)(ws + WS_CV) + (size_t)((b * 2 + l) * 256 + r0) * 1024 + h * 64 + ch * 8;
#pragma unroll
                for (int k = 0; k < 9; ++k) xl[k] = *(const u32x4*)(vsrc + (size_t)((64 * k < nrows) ? k : 0) * 64 * 1024);
#pragma unroll
                for (int k = 0; k < 4; ++k) { xc[k] = *(const u32x4*)(csrc + (size_t)k * 64 * 1024); xk[k] = *(const u32x4*)(ksrc + (size_t)k * 64 * 1024); }
#pragma unroll
                for (int k = 0; k < 9; ++k) if (64 * k < nrows) *(LAS u32x4*)(lds + vswz(r0 + 64 * k, ch * 16)) = xl[k];
#pragma unroll
                for (int k = 0; k < 4; ++k) { *(LAS u32x4*)(lds + vswz(VCTX_ROW0 + r0 + 64 * k, ch * 16)) = xc[k]; *(LAS u32x4*)(lds + KCTX_OFF + (r0 + 64 * k) * 128 + ((ch ^ (r0 & 7)) << 4)) = xk[k]; }
            }
            const float* rp_g = FIN(IN_RPB) + (size_t)(l * 16 + h) * 465;
            for (int idx = tid; idx < 465; idx += 512) ((LAS float*)(lds + RPB_OFF))[idx] = rp_g[idx];
            if (tid == 0) QN[0] = nxt_;
            __syncthreads();
            nxt_ = QN[0];
            const int r = 2 * rp + (w >> 2), n = w & 3;
            const int rs = iclamp(r - 4, 0, 8), cs = iclamp(16 * n - 8, 0, 32);
            const int qtok = tokb + r * 64 + 16 * n + i16;
            bf16x8 qf[2]; { const bf16_t* qp = Qb + (size_t)qtok * 1024 + h * 64 + 8 * fq; qf[0] = *(const bf16x8*)qp; qf[1] = *(const bf16x8*)(qp + 32); }
            int qc = 16 * n + i16; asm volatile("" : "+v"(qc));
            const int wsq = iclamp(qc - 8, 0, 48);
            AttnState st; st.m = -__builtin_inff(); st.lsum = 0.f;
#pragma unroll
            for (int d = 0; d < 4; ++d) st.o[d] = (f32x4){0.f, 0.f, 0.f, 0.f};
            const bf16_t* kpl = Kb + (size_t)(tokb + rs * 64 + cs + i16) * 1024 + h * 64 + 8 * fq;
            attn_chunk<true, false>(st, qf, kpl, klds, lds, (rs - rs2) * 64 + cs, voff, (LAS const float*)(lds + RPB_OFF), qc, wsq, cs, rs - r + 7, fq);
            attn_chunk<false, true>(st, qf, nullptr, klds, lds, VCTX_ROW0, voff, nullptr, 0, 0, 0, 0, fq);
            float lt = st.lsum; lt += __shfl_xor(lt, 16); lt += __shfl_xor(lt, 32);
            const float inv = 1.0f / lt;
            bf16_t* op = Ob + (size_t)qtok * 1024 + h * 64 + 4 * fq;
#pragma unroll
            for (int d = 0; d < 4; ++d) { const f32x4 o = st.o[d] * inv; u32x2 wv; wv.x = cvt_pk_bf16(o[0], o[1]); wv.y = cvt_pk_bf16(o[2], o[3]); *(u32x2*)(op + 16 * d) = wv; }
        } else {
            const int x = item - 512, b = x >> 5, h = (x >> 1) & 15, qh = x & 1;
            { const int r0 = tid >> 3, ch = tid & 7; u32x4 xc[4], xk[4]; const bf16_t* vsrc = Vb + (size_t)(b * 256 + r0) * 1024 + h * 64 + ch * 8; const bf16_t* ksrc = Kb + (size_t)(b * 256 + r0) * 1024 + h * 64 + ch * 8;
#pragma unroll
                for (int k = 0; k < 4; ++k) { xc[k] = *(const u32x4*)(vsrc + (size_t)k * 64 * 1024); xk[k] = *(const u32x4*)(ksrc + (size_t)k * 64 * 1024); }
#pragma unroll
                for (int k = 0; k < 4; ++k) { *(LAS u32x4*)(lds + vswz(r0 + 64 * k, ch * 16)) = xc[k]; *(LAS u32x4*)(lds + KCTX_OFF + (r0 + 64 * k) * 128 + ((ch ^ (r0 & 7)) << 4)) = xk[k]; } }
            if (tid == 0) QN[0] = nxt_;
            __syncthreads();
            nxt_ = QN[0];
            const int qtok = b * 256 + qh * 128 + 16 * w + i16;
            bf16x8 qf[2]; { const bf16_t* qp = Qb + (size_t)qtok * 1024 + h * 64 + 8 * fq; qf[0] = *(const bf16x8*)qp; qf[1] = *(const bf16x8*)(qp + 32); }
            AttnState st; st.m = -__builtin_inff(); st.lsum = 0.f;
#pragma unroll
            for (int d = 0; d < 4; ++d) st.o[d] = (f32x4){0.f, 0.f, 0.f, 0.f};
            attn_chunk<false, true>(st, qf, nullptr, klds, lds, 0, voff, nullptr, 0, 0, 0, 0, fq);
            float lt = st.lsum; lt += __shfl_xor(lt, 16); lt += __shfl_xor(lt, 32);
            const float inv = 1.0f / lt;
            bf16_t* op = Ob + (size_t)qtok * 1024 + h * 64 + 4 * fq;
#pragma unroll
            for (int d = 0; d < 4; ++d) { const f32x4 o = st.o[d] * inv; u32x2 wv; wv.x = cvt_pk_bf16(o[0], o[1]); wv.y = cvt_pk_bf16(o[2], o[3]); *(u32x2*)(op + 16 * d) = wv; }
        }
        qe = __builtin_amdgcn_readfirstlane(nxt_);
    }
    __syncthreads();
}

constexpr int N_PHASES = 17;
__global__ void __launch_bounds__(512, 2) mk_fwd(Args args) {
    extern __shared__ __attribute__((aligned(16))) unsigned char lds_raw[];
    Frame F;
    F.lds = (LAS unsigned char*)lds_raw;
    F.wave = __builtin_amdgcn_readfirstlane((int)threadIdx.x >> 6); F.G = gridDim.x; F.bid = blockIdx.x;
    F.out = args.out; F.ws = args.ws;
    volatile LAS unsigned* MISC = (volatile LAS unsigned*)(F.lds + LDSCTL_OFF);
    for (int u = FTID(F); u < 2048 / 4; u += 512) ((LAS unsigned*)(F.lds + LDSCTL_OFF))[u] = 0u;
    __syncthreads();
    const int lo = args.ph_lo, hi = args.ph_hi;
    XcdBarrier bar; bar.bar = (unsigned*)(F.ws + WS_CTL); bar.x = 0; bar.st = nullptr;
    if (hi - lo > 1) bar = xcd_barrier_post((unsigned*)(F.ws + WS_CTL), MISC + 8);
#ifndef MK_REPEAT_PH
#define MK_REPEAT_PH -1
#endif
    for (int pp = lo; pp < hi + (MK_REPEAT_PH >= 0 ? 1 : 0); ++pp) {
        const int ph = (MK_REPEAT_PH >= 0 && pp > MK_REPEAT_PH) ? pp - 1 : pp;
        int g256 = F.G; asm volatile("" : "+s"(g256));
        const bool split = (g256 == 256);
        constexpr int NGEMM1 = 205, NGEMM4 = 235, NLATE = 7000;
        int cv_lo = 0, cv_hi = 0, cv_gw = 0, cv_n = 1;
        if (ph == 0) { p0_phase(F); cv_hi = split ? I_EARLY : 2 * I_LAYER; cv_gw = F.bid * 8 + F.wave; cv_n = F.G * 8; }
        else {
            const int l = (ph - 1) / 8, s = (ph - 1) % 8;
            const bool fusedn = (g256 == 256);
            if (fusedn && (s == 5 || s == 0)) continue;
            if (s == 0) norm_phase(F, l, 0);
            if (s == 5) norm_phase(F, l, 1);
            int gt = -1, geff = F.G;
            if (s == 1) gt = GT_G1; else if (s == 2) gt = GT_DFTPOS; else if (s == 3) gt = GT_G2; else if (s == 4) gt = GT_G3; else if (s == 6) gt = GT_G4; else if (s == 7) gt = GT_G5;
            if (split && ph == 2) { geff = NGEMM1; if (F.bid >= NGEMM1) { gt = -1; cv_lo = I_EARLY; cv_hi = 2 * I_LAYER - NLATE; cv_gw = (F.bid - NGEMM1) * 8 + F.wave; cv_n = (256 - NGEMM1) * 8; } }
            if (split && ph == 7) { geff = NGEMM4; if (F.bid >= NGEMM4) { gt = -1; cv_lo = 2 * I_LAYER - NLATE; cv_hi = 2 * I_LAYER; cv_gw = (F.bid - NGEMM4) * 8 + F.wave; cv_n = (256 - NGEMM4) * 8; } }
#ifndef MK_ATTN_REP
#define MK_ATTN_REP 1
#endif
#ifndef MK_DFT_REP
#define MK_DFT_REP 1
#endif
            int nrep_g = (s == 2) ? MK_DFT_REP : 1, nrep_a = MK_ATTN_REP; asm volatile("" : "+s"(nrep_g), "+s"(nrep_a));
            const bool g4h = split && (ph == 15);
            if (g4h) gt = GT_G4M;
            if (gt >= 0) for (int rep = 0; rep < nrep_g; ++rep) gemm_phase(F, gt, l, geff);
            if (g4h) gemm_half_g4(F, l);
            if (s == 2) for (int rep = 0; rep < nrep_a; ++rep) attn_phase(F, l);
        }
        if (cv_hi > cv_lo) convert_range(F, cv_lo, cv_hi, cv_gw, cv_n);
        if (ph == 0 && split) {
            if (FTID(F) == 0) { unsigned sp = 0; while (__hip_atomic_load((unsigned*)(F.ws + WS_CTL + 110592), __ATOMIC_RELAXED, __HIP_MEMORY_SCOPE_AGENT) < 43u && ++sp < (1u << 22)) __builtin_amdgcn_s_sleep(2);
                __builtin_amdgcn_fence(__ATOMIC_ACQUIRE, "agent"); asm volatile("s_waitcnt vmcnt(0)" ::: "memory"); }
            __syncthreads();
            norm_phase(F, 0, 0);
        }
        if (ph + 1 < hi) xcd_barrier(bar);
    }
}


#if defined(MK_DEBUG_CHECK)
__device__ __forceinline__ float bf2f(bf16_t v) { return __uint_as_float(((unsigned)v) << 16); }
__device__ __forceinline__ float f2bf2f(float f) { unsigned u = __float_as_uint(f); u += 0x7fffu + ((u >> 16) & 1u); return __uint_as_float(u & 0xffff0000u); }
__device__ __forceinline__ unsigned hash32(unsigned x) { x ^= x >> 16; x *= 0x7feb352dU; x ^= x >> 15; x *= 0x846ca68bU; x ^= x >> 16; return x; }
__device__ __forceinline__ void dbg_report(unsigned* slot, float e) { if (!(e >= 0.f)) e = 1e30f; atomicMax(slot, __float_as_uint(e)); }
__global__ void __launch_bounds__(64) dbg_check(Args a, int mode, int l) {
    const unsigned sid = blockIdx.x * blockDim.x + threadIdx.x; const unsigned hs = hash32(sid * 2654435761u + 12345u + mode * 977u);
    unsigned char* ws = a.ws; unsigned* slot = (unsigned*)(ws + WS_CTL + 32768) + mode;
    const float* MOD = (const float*)(ws + WS_MOD);
    if (mode == 0) {
        const int row = hs % NTOK, col = (hs >> 13) % DM; const float* xr = row < NPR ? FIN(IN_XP) + (size_t)row * DM : FIN(IN_XS) + (size_t)(row - NPR) * DM;
        float ss = 0.f; for (int k = 0; k < DM; ++k) ss += xr[k] * xr[k];
        const int cnd = row < NPR ? 4 : ((row - NPR) >> 10); const float* cv = cnd < 4 ? FIN(IN_C) + cnd * DM : FIN(IN_CCTX);
        float sh = FIN(IN_BMOD)[l * NMOD + col], sc = FIN(IN_BMOD)[l * NMOD + DM + col];
        for (int k = 0; k < DM; ++k) { const float v = cv[k], sv = v / (1.f + expf(-v)); sh += sv * FIN(IN_WMOD)[((size_t)l * DM + k) * NMOD + col]; sc += sv * FIN(IN_WMOD)[((size_t)l * DM + k) * NMOD + DM + col]; }
        const float ref = xr[col] * (1.f / sqrtf(ss / DM + EPS)) * FIN(IN_N1)[l * DM + col] * (1.f + sc) + sh;
        const float got = bf2f(((const bf16_t*)(ws + WS_H))[(size_t)row * DM + col]);
        dbg_report(slot, fabsf(got - ref) / (fabsf(ref) + 0.05f));
    } else if (mode == 1 || mode == 3) {
        const int row = hs % NTOK, col = (hs >> 13) % (mode == 1 ? 1024 : 4096); const bf16_t* hr = (const bf16_t*)(ws + WS_H) + (size_t)row * DM;
        const float* W = (mode == 1 ? FIN(IN_WIN) + (size_t)l * DM * 4096 + 2048 : FIN(IN_WGATE) + (size_t)l * DM * 4096) + col;
        float acc = 0.f, sa = 0.f; for (int k = 0; k < DM; ++k) { const float p = bf2f(hr[k]) * f2bf2f(W[(size_t)k * 4096]); acc += p; sa += fabsf(p); }
        float got, ref;
        if (mode == 1) { ref = acc; got = bf2f(((const bf16_t*)(ws + WS_V))[(size_t)row * 1024 + col]); }
        else { ref = 1.f / (1.f + expf(-acc)); h16x2 hh = __builtin_bit_cast(h16x2, (unsigned)((const unsigned short*)(ws + WS_G))[(size_t)row * 4096 + col]); got = (float)hh.x; }
        dbg_report(slot, fabsf(got - ref) / (mode == 1 ? (0.02f * sa + 1e-3f) : 1.0f));
    } else if (mode == 2) {
        const int row = hs % NTOK, head = (hs >> 13) % 16, d0 = (hs >> 17) % 64; const bf16_t* hr = (const bf16_t*)(ws + WS_H) + (size_t)row * DM;
        float ss = 0.f, mine = 0.f;
        for (int d = 0; d < 64; ++d) { const float* W = FIN(IN_WIN) + (size_t)l * DM * 4096 + head * 64 + d; float acc = 0.f; for (int k = 0; k < DM; ++k) acc += bf2f(hr[k]) * f2bf2f(W[(size_t)k * 4096]); ss += acc * acc; if (d == d0) mine = acc; }
        const float ref = mine * (1.f / sqrtf(ss / 64.f + EPS)) * FIN(IN_QG)[l * 64 + d0] * 0.125f;
        const float got = bf2f(((const bf16_t*)(ws + WS_Q))[(size_t)row * 1024 + head * 64 + d0]);
        dbg_report(slot, fabsf(got - ref) / 0.125f);
    } else if (mode == 4 || mode == 5) {
        const bf16_t* Qb = (const bf16_t*)(ws + WS_Q); const bf16_t* Kb = (const bf16_t*)(ws + WS_K); const bf16_t* Vb = (const bf16_t*)(ws + WS_V);
        const int h = (hs >> 13) % 16; int tok;
        if (mode == 4) tok = NPR + hs % 4096; else tok = hs % NPR;
        __shared__ float sq_[64 * 64], so_[64 * 64];
#define q(d) sq_[(d) * 64 + threadIdx.x]
#define o(d) so_[(d) * 64 + threadIdx.x]
        for (int d = 0; d < 64; ++d) q(d) = bf2f(Qb[(size_t)tok * 1024 + h * 64 + d]);
        float mx = -1e30f, lsum = 0.f; for (int d = 0; d < 64; ++d) o(d) = 0.f;
        for (int pass = 0; pass < 2; ++pass) {
            if (mode == 4) {
                const int b = (tok - NPR) >> 10, tt = (tok - NPR) & 1023, r = tt >> 6, qc = tt & 63, rs = iclamp(r - 4, 0, 8), wsq = iclamp(qc - 8, 0, 48);
#if !defined(MK_NATT_VARIANT) || MK_NATT_VARIANT != 1
                for (int i = 0; i < 8; ++i) for (int j = 0; j < 16; ++j) { const int kr = rs + i, kc = wsq + j, kt = NPR + b * 1024 + kr * 64 + kc;
                    float sc = 0.f; for (int d = 0; d < 64; ++d) sc += q(d) * bf2f(Kb[(size_t)kt * 1024 + h * 64 + d]);
                    sc += FIN(IN_RPB)[(size_t)(l * 16 + h) * 465 + (kr - r + 7) * 31 + iclamp(kc - qc + 15, 0, 30)];
                    if (pass == 0) mx = fmaxf(mx, sc); else { const float p = expf(sc - mx); lsum += p; for (int d = 0; d < 64; ++d) o(d) += p * bf2f(Vb[(size_t)kt * 1024 + h * 64 + d]); } }
#endif
#if !defined(MK_NATT_VARIANT) || MK_NATT_VARIANT != 2
                for (int j = 0; j < 256; ++j) { const size_t kt = (size_t)((b * 2 + l) * 256 + j);
                    float sc = 0.f; for (int d = 0; d < 64; ++d) sc += q(d) * FIN(IN_CK)[kt * 1024 + h * 64 + d];
                    if (pass == 0) mx = fmaxf(mx, sc); else { const float p = expf(sc - mx); lsum += p; for (int d = 0; d < 64; ++d) o(d) += p * FIN(IN_CV)[kt * 1024 + h * 64 + d]; } }
#endif
            } else {
                const int b = tok >> 8;
                for (int j = 0; j < 256; ++j) { const int kt = b * 256 + j;
                    float sc = 0.f; for (int d = 0; d < 64; ++d) sc += q(d) * bf2f(Kb[(size_t)kt * 1024 + h * 64 + d]);
                    if (pass == 0) mx = fmaxf(mx, sc); else { const float p = expf(sc - mx); lsum += p; for (int d = 0; d < 64; ++d) o(d) += p * bf2f(Vb[(size_t)kt * 1024 + h * 64 + d]); } }
            }
        }
        float rms = 0.f, err = 0.f; for (int d = 0; d < 64; ++d) { const float ref = o(d) / lsum; rms += ref * ref; err = fmaxf(err, fabsf(bf2f(((const bf16_t*)(ws + WS_ATT))[(size_t)tok * 1024 + h * 64 + d]) - ref)); }
        { const float e_ = err / (sqrtf(rms / 64.f) + 1e-3f); dbg_report(slot, e_);
          unsigned* cnt = (unsigned*)(ws + WS_CTL + 32768) + 16;
          if (e_ > 0.1f) { atomicAdd(cnt + (mode - 4), 1u);
            if (mode == 4) { const int tt = (tok - NPR) & 1023; atomicAdd(cnt + 4 + (tt >> 6), 1u); atomicAdd(cnt + 20 + ((tt & 63) >> 4), 1u); atomicAdd(cnt + 24 + h, 1u); } } }
#undef q
#undef o
    } else if (mode == 6) {
        const int tok = hs % NTOK, ch = (hs >> 13) % 1024, g = ch >> 8, m = ch & 255; int T, t; const bf16_t* ut;
        if (tok < NPR) { T = 256; t = tok & 255; ut = (const bf16_t*)(ws + WS_UTP) + (size_t)(tok >> 8) * 1024 * 1024; }
        else { T = 1024; t = (tok - NPR) & 1023; ut = (const bf16_t*)(ws + WS_UTS) + (size_t)((tok - NPR) >> 10) * 1024 * 1024; }
        float acc = 0.f, sa = 0.f;
        for (int c = 0; c < 256; ++c) { const bf16_t* ur = ut + (size_t)(g * 256 + rho256(c)) * 1024; const int pc = (m * c) & 255;
            for (int tp = 0; tp < T; ++tp) { const int pt = (t * tp) & (T - 1); const float x = 2.0f * ((float)pt / (float)T + (float)pc / 256.0f); const float v = bf2f(ur[tp]) * cospif(x); acc += v; sa += v * v; } }
        const float ref = acc / sqrtf((float)T * 256.f);
        const float got = bf2f(((const bf16_t*)(ws + WS_F))[(size_t)tok * 1024 + ch]);
        dbg_report(slot, fabsf(got - ref) / (sqrtf(sa / ((float)T * 256.f)) + 1e-3f));
    } else if (mode == 7) {
        const int row = hs % NTOK, col = (hs >> 13) % DM;
        const bf16_t* ar = (const bf16_t*)(ws + WS_ATT) + (size_t)row * 1024; const bf16_t* fr_ = (const bf16_t*)(ws + WS_F) + (size_t)row * 1024;
        float na = 0.f, fn = 0.f; for (int k = 0; k < 1024; ++k) { na += bf2f(ar[k]) * f2bf2f(FIN(IN_WNA)[((size_t)l * 1024 + k) * DM + col]); fn += bf2f(fr_[k]) * f2bf2f(FIN(IN_WFN)[((size_t)l * 1024 + k) * DM + col]); }
        const unsigned short* gr = (const unsigned short*)(ws + WS_G) + (size_t)row * 4096;
        h16x2 h1 = __builtin_bit_cast(h16x2, (unsigned)gr[col]), h2 = __builtin_bit_cast(h16x2, (unsigned)gr[2048 + col]);
        const float ref = (float)h1.x * na + (float)h2.x * fn;
        const float got = bf2f(((const bf16_t*)(ws + WS_MIX))[(size_t)row * DM + col]);
        dbg_report(slot, fabsf(got - ref) / (fabsf((float)h1.x * na) + fabsf((float)h2.x * fn) + 0.02f));
    } else if (mode == 8 || mode == 10) {
        const int row = hs % NTOK, col = (hs >> 13) % DM; const int cnd = row < NPR ? 4 : ((row - NPR) >> 10);
        float acc = 0.f, sa = 0.f; float base, gate, got;
        if (mode == 8) { const bf16_t* mr = (const bf16_t*)(ws + WS_MIX) + (size_t)row * DM; for (int k = 0; k < DM; ++k) { const float p = bf2f(mr[k]) * f2bf2f(FIN(IN_WO)[((size_t)l * DM + k) * DM + col]); acc += p; sa += fabsf(p); }
            base = row < NPR ? FIN(IN_XP)[(size_t)row * DM + col] : FIN(IN_XS)[(size_t)(row - NPR) * DM + col]; gate = MOD[(size_t)(l * 5 + cnd) * NMOD + 2 * DM + col]; got = ((const float*)(ws + WS_X1))[(size_t)row * DM + col]; }
        else { const bf16_t* mr = (const bf16_t*)(ws + WS_ACT) + (size_t)row * DFF; for (int k = 0; k < DFF; ++k) { const float p = bf2f(mr[k]) * f2bf2f(FIN(IN_WD)[((size_t)l * DFF + k) * DM + col]); acc += p; sa += fabsf(p); }
            base = ((const float*)(ws + WS_X1))[(size_t)row * DM + col]; gate = MOD[(size_t)(l * 5 + cnd) * NMOD + 5 * DM + col]; got = ((const float*)(ws + WS_X2))[(size_t)row * DM + col]; }
        const float ref = base + gate * acc;
        dbg_report(slot, fabsf(got - ref) / (0.02f * fabsf(gate) * sa + 1e-3f));
    } else if (mode == 9) {
        const int row = hs % NTOK, col = (hs >> 13) % DFF; const bf16_t* hr = (const bf16_t*)(ws + WS_H) + (size_t)row * DM;
        float aa = 0.f, gg = 0.f; for (int k = 0; k < DM; ++k) { const float hv = bf2f(hr[k]); aa += hv * f2bf2f(FIN(IN_WGU)[((size_t)l * DM + k) * 2 * DFF + col]); gg += hv * f2bf2f(FIN(IN_WGU)[((size_t)l * DM + k) * 2 * DFF + DFF + col]); }
        const float ref = aa * gg / (1.f + expf(-gg));
        const float got = bf2f(((const bf16_t*)(ws + WS_ACT))[(size_t)row * DFF + col]);
        dbg_report(slot, fabsf(got - ref) / (fabsf(ref) + 0.05f));
    }
}
__global__ void dbg_emit(Args a, int nmodes, float tol, int out_total) {
    const unsigned* slot = (const unsigned*)(a.ws + WS_CTL + 32768);
    for (int i = blockIdx.x * blockDim.x + threadIdx.x; i < out_total; i += gridDim.x * blockDim.x) a.out[i] = 0.f;
    __syncthreads();
    if (blockIdx.x == 0 && threadIdx.x == 0) {
#if defined(MK_DEBUG_COUNT)
        { unsigned c_ = slot[MK_DEBUG_COUNT] + 1u; int bk = 0; while (c_ > 1u) { c_ >>= 1; ++bk; } float V = 1e3f; for (int i = 0; i < bk; ++i) V *= 10.f; a.out[0] = V; }
#elif defined(MK_DEBUG_VALUE)
        a.out[0] = __uint_as_float(slot[MK_DEBUG_VALUE]) * 1e7f;
#else
        float V = 0.f; float dec = 1e3f;
        for (int m = 0; m < nmodes; ++m) { if (__uint_as_float(slot[m]) > tol && V == 0.f) V = dec; dec *= 10.f; }
        a.out[0] = V;
#endif
    }
}
#endif

extern "C" void kernel_launch(void* const* d_in, const int* in_sizes, int n_in, void* d_out, int out_size, void* d_ws, size_t ws_size, hipStream_t stream) {
    static int grid = 0;
    if (grid == 0) {
        if (n_in != 20 || ws_size < WS_END) { fprintf(stderr, "kernel_launch: unexpected n_in %d / ws_size %zu (need %zu)\n", n_in, ws_size, (size_t)WS_END); grid = -1; return; }
        int dev = 0, cus = 0, per_cu = 0;
        if (hipGetDevice(&dev) != hipSuccess || hipDeviceGetAttribute(&cus, hipDeviceAttributeMultiprocessorCount, dev) != hipSuccess) { grid = -1; return; }
        if (hipFuncSetAttribute((const void*)mk_fwd, hipFuncAttributeMaxDynamicSharedMemorySize, LDS_BYTES) != hipSuccess) { fprintf(stderr, "kernel_launch: hipFuncSetAttribute failed\n"); grid = -1; return; }
        if (hipOccupancyMaxActiveBlocksPerMultiprocessor(&per_cu, (const void*)mk_fwd, 512, LDS_BYTES) != hipSuccess || per_cu < 1) fprintf(stderr, "kernel_launch: occupancy query says %d\n", per_cu);
        (void)hipGetLastError();
        grid = cus;
        if (grid != 256) fprintf(stderr, "kernel_launch: %d CUs\n", grid);
    }
    if (grid < 0) return;
    (void)hipMemsetAsync((char*)d_ws + WS_CTL, 0, CTL_BYTES, stream);
    Args a{};
    for (int i = 0; i < 20; ++i) a.in[i] = (const float*)d_in[i];
    a.out = (float*)d_out; a.ws = (unsigned char*)d_ws;
#ifndef MK_PH_LIMIT
#define MK_PH_LIMIT N_PHASES
#endif
#if MK_LAUNCH_PER_PHASE
    for (int ph = 0; ph < MK_PH_LIMIT; ++ph) { a.ph_lo = ph; a.ph_hi = ph + 1; hipLaunchKernelGGL(mk_fwd, dim3(grid), dim3(512), LDS_BYTES, stream, a);
#if defined(MK_DEBUG_CHECK)
        { const int l = 0;
          if (ph == 1) hipLaunchKernelGGL(dbg_check, dim3(16), dim3(64), 0, stream, a, 0, l);
          if (ph == 2) { hipLaunchKernelGGL(dbg_check, dim3(64), dim3(64), 0, stream, a, 1, l); hipLaunchKernelGGL(dbg_check, dim3(16), dim3(64), 0, stream, a, 2, l); hipLaunchKernelGGL(dbg_check, dim3(64), dim3(64), 0, stream, a, 3, l); }
          if (ph == 3) { hipLaunchKernelGGL(dbg_check, dim3(64), dim3(64), 0, stream, a, 4, l); hipLaunchKernelGGL(dbg_check, dim3(64), dim3(64), 0, stream, a, 5, l); }
          if (ph == 4) hipLaunchKernelGGL(dbg_check, dim3(32), dim3(64), 0, stream, a, 6, l);
          if (ph == 5) hipLaunchKernelGGL(dbg_check, dim3(64), dim3(64), 0, stream, a, 7, l);
          if (ph == 6) hipLaunchKernelGGL(dbg_check, dim3(64), dim3(64), 0, stream, a, 8, l);
          if (ph == 8) hipLaunchKernelGGL(dbg_check, dim3(64), dim3(64), 0, stream, a, 9, l);
          if (ph == 9) hipLaunchKernelGGL(dbg_check, dim3(64), dim3(64), 0, stream, a, 10, l); }
#endif
    }
#if defined(MK_DEBUG_CHECK)
    hipLaunchKernelGGL(dbg_emit, dim3(256), dim3(256), 0, stream, a, 11, MK_DEBUG_TOL, out_size);
#endif
#else
    a.ph_lo = 0; a.ph_hi = N_PHASES;
    hipLaunchKernelGGL(mk_fwd, dim3(grid), dim3(512), LDS_BYTES, stream, a);
#endif
}
```

```cpp
#include <hip/hip_runtime.h>
#include <cstdio>
#include <cstdint>


#ifndef MK_LAUNCH_PER_PHASE
#define MK_LAUNCH_PER_PHASE 0
#endif

#define LAS __attribute__((address_space(3)))
typedef unsigned short bf16_t;
typedef short bf16x8 __attribute__((ext_vector_type(8)));
typedef short s16x4 __attribute__((ext_vector_type(4)));
typedef float f32x4 __attribute__((ext_vector_type(4)));
typedef unsigned u32x4 __attribute__((ext_vector_type(4)));
typedef unsigned u32x2 __attribute__((ext_vector_type(2)));
typedef _Float16 h16x2 __attribute__((ext_vector_type(2)));
typedef short v4i16_t __attribute__((ext_vector_type(4)));

constexpr int DM = 2048, NTOK = 8192, NPR = 4096, DFF = 5632, NMOD = 12288;
constexpr float EPS = 1e-6f, LOG2E = 1.4426950408889634f;
constexpr size_t OUT_NEWK = 8192ull * 2048, OUT_NEWV = OUT_NEWK + 16ull * 2 * 256 * 1024;

constexpr size_t MiB = 1u << 20;
constexpr size_t WS_CTL = 0, CTL_BYTES = 128 * 1024;
constexpr size_t WS_MOD = 1 * MiB;
constexpr size_t WS_DCT = 2 * MiB;
constexpr size_t WS_DT256 = 3 * MiB;
constexpr size_t WS_DT1024 = 4 * MiB;
constexpr size_t WS_CK = 8 * MiB, WS_CV = 12 * MiB;
constexpr size_t WS_W = 16 * MiB, W_LAYER = 114 * MiB;
constexpr size_t WO_W1 = 0, WO_NA = 32 * MiB, WO_FN = 36 * MiB, WO_O = 40 * MiB, WO_GU = 48 * MiB, WO_D = 92 * MiB;
constexpr size_t WS_H = 244 * MiB;
constexpr size_t WS_Q = 276 * MiB, WS_K = 292 * MiB, WS_V = 308 * MiB;
constexpr size_t WS_UTS = 324 * MiB;
constexpr size_t WS_UTP = 332 * MiB;
constexpr size_t WS_G = 364 * MiB;
constexpr size_t WS_ATT = 428 * MiB;
constexpr size_t WS_Y = 444 * MiB;
constexpr size_t WS_F = 476 * MiB;
constexpr size_t WS_MIX = 492 * MiB;
constexpr size_t WS_X1 = 524 * MiB;
constexpr size_t WS_ACT = 364 * MiB;
constexpr size_t WS_X2 = 588 * MiB;
constexpr size_t WS_PART = 652 * MiB;
constexpr size_t WS_END = 653 * MiB;

constexpr int RING_BYTES = 131072, LDSCTL_OFF = 143360, LDS_BYTES = 145408;

#define LDS_WAIT() asm volatile("s_waitcnt lgkmcnt(0)" ::: "memory")
#define VM_WAIT() asm volatile("s_waitcnt vmcnt(0)" ::: "memory")
typedef float f32x2_t __attribute__((ext_vector_type(2)));
typedef __bf16 bf16x2_t __attribute__((ext_vector_type(2)));
__device__ __forceinline__ unsigned cvt_pk_bf16(float lo, float hi) { f32x2_t v = {lo, hi}; bf16x2_t b = __builtin_convertvector(v, bf16x2_t); return __builtin_bit_cast(unsigned, b); }
__device__ __forceinline__ unsigned pk_h16(float lo, float hi) { h16x2 h; h.x = (_Float16)lo; h.y = (_Float16)hi; return __builtin_bit_cast(unsigned, h); }
__device__ __forceinline__ float h16_lo(unsigned u) { h16x2 h = __builtin_bit_cast(h16x2, u); return (float)h.x; }
__device__ __forceinline__ float h16_hi(unsigned u) { h16x2 h = __builtin_bit_cast(h16x2, u); return (float)h.y; }
__device__ __forceinline__ float fexp2(float x) { return __builtin_amdgcn_exp2f(x); }
__device__ __forceinline__ float frcp(float x) { return __builtin_amdgcn_rcpf(x); }
__device__ __forceinline__ float sigmoidf_(float x) { return frcp(1.0f + fexp2(-x * LOG2E)); }
#define GAS __attribute__((address_space(1)))
__device__ __forceinline__ f32x4 ldg_f4(const void* p) { return *(const GAS f32x4*)p; }
__device__ __forceinline__ u32x4 ldg_u4(const void* p) { return *(const GAS u32x4*)p; }
__device__ __forceinline__ void stg_f4(void* p, f32x4 v) { *(GAS f32x4*)p = v; }
__device__ __forceinline__ void stg_u4(void* p, u32x4 v) { *(GAS u32x4*)p = v; }
__device__ __forceinline__ void stg_u2(void* p, u32x2 v) { *(GAS u32x2*)p = v; }
__device__ __forceinline__ int iclamp(int v, int lo, int hi) { return v < lo ? lo : (v > hi ? hi : v); }
__device__ __forceinline__ int rho256(int L) { return 128 * ((L >> 5) & 1) + 32 * (L >> 6) + 16 * ((L >> 2) & 1) + 4 * ((L >> 3) & 3) + (L & 3); }
__device__ __forceinline__ int rho256_inv(int r) { const int bj = r >> 7, wc = (r >> 5) & 3, n = (r >> 4) & 1, fq = (r >> 2) & 3, j = r & 3; return 64 * wc + 32 * bj + 8 * fq + 4 * n + j; }

#define XB_TMO      128
#define XB_XCNT(j)  (256  + 64 * (j))
#define XB_XSUB(j)  (1280 + 64 * (j))
#define XB_XGEN(j)  (2304 + 64 * (j))
#define XB_TOP      3328
#define XB_TOPGEN   3392
#define XCD_BAR_WORDS 3456
#define XB_SPIN_CAP (1u << 20)
__device__ __forceinline__ unsigned xb_ld(unsigned* p)              { return __hip_atomic_load(p, __ATOMIC_RELAXED, __HIP_MEMORY_SCOPE_AGENT); }
__device__ __forceinline__ unsigned xb_add(unsigned* p, unsigned v) { return __hip_atomic_fetch_add(p, v, __ATOMIC_RELAXED, __HIP_MEMORY_SCOPE_AGENT); }
__device__ __forceinline__ unsigned xb_xcc_id() { return (unsigned)__builtin_amdgcn_s_getreg((3 << 11) | 20) & 0xFu; }
#define XB_SPIN(cond, bar) do { unsigned _sp = 0; while (cond) { __builtin_amdgcn_s_sleep(1); \
    if ((++_sp & 255u) == 0u) { if (xb_ld(&(bar)[XB_TMO])) break; if (_sp > XB_SPIN_CAP) { atomicAdd(&(bar)[XB_TMO], 1u); break; } } } } while (0)
struct XcdBarrier { unsigned* bar; unsigned x; volatile LAS unsigned* st; };
__device__ __forceinline__ XcdBarrier xcd_barrier_post(unsigned* bar, volatile LAS unsigned* st) {
    XcdBarrier b; b.bar = bar; b.x = xb_xcc_id(); b.st = st;
    if (threadIdx.x == 0) (void)xb_add(&bar[XB_XCNT(b.x)], 1u);
    return b;
}
__device__ __forceinline__ void xcd_barrier_complete(unsigned* bar, unsigned x, unsigned& nloc, unsigned& nx) {
    const unsigned G = gridDim.x * gridDim.y * gridDim.z;
    unsigned sum, cnt, mine, sp = 0u;
    for (;;) {
        sum = 0u; cnt = 0u; mine = 0u;
#pragma unroll
        for (unsigned j = 0; j < 16; ++j) { const unsigned c = xb_ld(&bar[XB_XCNT(j)]); sum += c; cnt += (c > 0u) ? 1u : 0u; mine = (j == x) ? c : mine; }
        if (sum == G) break;
        __builtin_amdgcn_s_sleep(1);
        if ((++sp & 255u) == 0u) { if (xb_ld(&bar[XB_TMO])) break; if (sp > XB_SPIN_CAP) { atomicAdd(&bar[XB_TMO], 1u); break; } }
    }
    nloc = mine > 0u ? mine : 1u; nx = cnt > 0u ? cnt : 1u;
}
__device__ __forceinline__ void xcd_barrier(const XcdBarrier& b) {
    asm volatile("s_waitcnt vmcnt(0)" ::: "memory");
    __syncthreads();
    if (threadIdx.x == 0) {
        unsigned* bar = b.bar;
        __builtin_amdgcn_s_waitcnt(0);
        unsigned nloc = b.st[0], nx = b.st[1];
        if (nloc == 0u) { xcd_barrier_complete(bar, b.x, nloc, nx); b.st[0] = nloc; b.st[1] = nx; }
        const unsigned old = xb_add(&bar[XB_XSUB(b.x)], 1u);
        const unsigned gen = old / nloc;
        if (old + 1u == (gen + 1u) * nloc) {
            __builtin_amdgcn_fence(__ATOMIC_RELEASE, "agent");
            asm volatile("s_waitcnt vmcnt(0)" ::: "memory");
            const unsigned og = xb_add(&bar[XB_TOP], 1u);
            const unsigned tg = og / nx;
            if (og + 1u == (tg + 1u) * nx) xb_add(&bar[XB_TOPGEN], 1u);
            else XB_SPIN(xb_ld(&bar[XB_TOPGEN]) == tg, bar);
            __builtin_amdgcn_fence(__ATOMIC_ACQUIRE, "agent");
            xb_add(&bar[XB_XGEN(b.x)], 1u);
            asm volatile("s_waitcnt vmcnt(0)" ::: "memory");
        } else {
            XB_SPIN(xb_ld(&bar[XB_XGEN(b.x)]) == gen, bar);
            __builtin_amdgcn_fence(__ATOMIC_ACQUIRE, "agent");
            asm volatile("s_waitcnt vmcnt(0)" ::: "memory");
        }
    }
    __syncthreads();
}

struct Args { const float* in[20]; float* out; unsigned char* ws; int ph_lo, ph_hi; };
typedef __attribute__((address_space(4))) const Args CArgs;
struct Frame {
    LAS unsigned char* lds;
    int wave, G, bid;
    float* out; unsigned char* ws;
};
#define FIN(i) (((CArgs*)__builtin_amdgcn_kernarg_segment_ptr())->in[i])
__device__ __forceinline__ int lane_id_volatile() { int l_; asm volatile("v_mbcnt_lo_u32_b32 %0, -1, 0\n\tv_mbcnt_hi_u32_b32 %0, -1, %0" : "=v"(l_)); return l_; }
#define FTID(F) ((F).wave * 64 + lane_id_volatile())
#define IN_XP 0
#define IN_XS 1
#define IN_CK 2
#define IN_CV 3
#define IN_C 4
#define IN_CCTX 5
#define IN_WMOD 6
#define IN_BMOD 7
#define IN_N1 8
#define IN_N2 9
#define IN_WIN 10
#define IN_QG 11
#define IN_KG 12
#define IN_RPB 13
#define IN_WNA 14
#define IN_WFN 15
#define IN_WGATE 16
#define IN_WO 17
#define IN_WGU 18
#define IN_WD 19

__device__ __forceinline__ int cond_of_pm(int pm) { return pm < 16 ? 4 : ((pm - 16) >> 2); }

constexpr int BM = 256, BK = 64, HALF = 128, HTB = HALF * BK * 2, NXCD = 8, WGM = 8;
__device__ __forceinline__ int lds_byte(int r, int c) { const int st = (r >> 4) * 2 + (c >> 5), rr = r & 15, cc = c & 31, ob = rr * 64 + cc * 2; return st * 1024 + (ob ^ (((ob >> 9) & 1) << 5)); }
__device__ __forceinline__ void stage_rc(int b, int& R, int& C) { const int st = b / 1024, sb = b % 1024, swz = sb ^ (((sb >> 9) & 1) << 5); R = (st >> 1) * 16 + swz / 64; C = (st & 1) * 32 + (swz % 64) / 2; }

#ifndef MK_SP2
#define MK_SP2 true
#endif
#ifndef MK_ALIGN
#define MK_ALIGN true
#endif
constexpr bool GEMM_SP2 = MK_SP2, GEMM_ALIGN_EPI = MK_ALIGN;
enum GemmType { GT_G1 = 0, GT_DFTPOS = 1, GT_DFTCH = 2, GT_G2 = 3, GT_G3 = 4, GT_G4 = 5, GT_G5 = 6, GT_G4M = 7 };
enum EpiKind { K_Q = 0, K_K, K_V, K_UT, K_G, K_Y, K_F, K_MIXA, K_MIXB, K_X1, K_ACT, K_X2 };
typedef const GAS char* gcptr;
struct Unit { gcptr A; gcptr B; int nt, kind, pm, pn, orow, ocol; };

__device__ __forceinline__ void tile_order(int L, int nM, int nN, int& pm, int& pn) {
    const int nwg = nM * nN; int wgid = L;
    { const int q = nwg / NXCD, r = nwg % NXCD, xcd = wgid % NXCD, off = wgid / NXCD; wgid = (xcd < r ? xcd * (q + 1) : r * (q + 1) + (xcd - r) * q) + off; }
    const int nig = WGM * nN, gid = wgid / nig, fm = gid * WGM, gsz = (nM - fm) < WGM ? (nM - fm) : WGM;
    pm = fm + ((wgid % nig) % gsz); pn = (wgid % nig) / gsz;
}

__device__ __forceinline__ bool get_unit(const Frame& F, int gt, int l, int i, int Geff, Unit& u) {
    size_t wso = 0; asm volatile("" : "+s"(wso));
    gcptr ws = (gcptr)F.ws + wso; const int G = Geff, c = F.bid;
    gcptr wl = ws + WS_W + (size_t)l * W_LAYER;
    u.orow = 0; u.ocol = 0;
    switch (gt) {
    case GT_G1: {
        const int L = i * G + c; if (L >= 32 * 32) return false;
        int pm, pn; tile_order(L, 32, 32, pm, pn); u.pm = pm; u.pn = pn; u.nt = 32;
        gcptr hrow = ws + WS_H + (size_t)pm * 256 * DM * 2; gcptr wrow = wl + WO_W1 + (size_t)pn * 256 * DM * 2;
        if (pn >= 12 && pn < 16) { u.A = wrow; u.B = hrow; u.kind = K_UT; u.ocol = (pn - 12) * 256; }
        else { u.A = hrow; u.B = wrow; u.kind = pn < 4 ? K_Q : (pn < 8 ? K_K : (pn < 12 ? K_V : K_G)); u.ocol = (pn < 4 ? pn : (pn < 8 ? pn - 4 : (pn < 12 ? pn - 8 : pn - 16))) * 256; }
        return true; }
    case GT_DFTPOS: {
        const int p = c + (i / 3) * G, sub = i % 3; if (p >= 128) return false;
        int b, mt, g, pm, T4;
        if (p < 64) { b = p >> 4; mt = (p >> 2) & 3; g = p & 3; pm = 16 + b * 4 + mt; T4 = 16; } else { b = (p - 64) >> 2; mt = 0; g = p & 3; pm = b; T4 = 4; }
        u.pm = pm; u.pn = g;
        if (sub < 2) { u.kind = K_Y; u.nt = T4; u.ocol = sub; u.orow = pm * 256;
            u.A = (p < 64) ? ws + WS_DT1024 + (size_t)(sub * 1024 + mt * 256) * 1024 * 2 : ws + WS_DT256 + (size_t)(sub * 256) * 1024 * 2;
            u.B = (p < 64) ? ws + WS_UTS + (size_t)(b * 1024 + g * 256) * 1024 * 2 : ws + WS_UTP + (size_t)(b * 1024 + g * 256) * 1024 * 2; }
        else { u.kind = K_F; u.nt = 8; u.orow = pm * 256; u.ocol = g * 256;
            u.A = ws + WS_Y + (((size_t)(g >> 1) * NTOK + pm * 256) * 1024 + (g & 1) * 512) * 2; u.B = ws + WS_DCT; }
        return true; }
    case GT_G2: {
        const int L = (i >> 1) * G + c; if (L >= 256) return false;
        int pm, pn; tile_order(L, 32, 8, pm, pn); u.pm = pm; u.pn = pn; u.nt = 16;
        if ((i & 1) == 0) { u.A = ws + WS_ATT + (size_t)pm * 256 * 1024 * 2; u.B = wl + WO_NA + (size_t)pn * 256 * 1024 * 2; u.kind = K_MIXA; }
        else { u.A = ws + WS_F + (size_t)pm * 256 * 1024 * 2; u.B = wl + WO_FN + (size_t)pn * 256 * 1024 * 2; u.kind = K_MIXB; }
        return true; }
    case GT_G3: {
        const int L = i * G + c; if (L >= 256) return false;
        int pm, pn; tile_order(L, 32, 8, pm, pn); u.pm = pm; u.pn = pn; u.nt = 32; u.kind = K_X1;
        u.A = ws + WS_MIX + (size_t)pm * 256 * DM * 2; u.B = wl + WO_O + (size_t)pn * 256 * DM * 2;
        return true; }
    case GT_G4: case GT_G4M: {
        const int L = i * G + c; if (L >= 32 * 44 || (gt == GT_G4M && i >= 5)) return false;
        int pm, pn; tile_order(L, 32, 44, pm, pn); u.pm = pm; u.pn = pn; u.nt = 32; u.kind = K_ACT;
        u.A = ws + WS_H + (size_t)pm * 256 * DM * 2; u.B = wl + WO_GU + (size_t)pn * 256 * DM * 2;
        return true; }
    default: {
        const int L = i * G + c; if (L >= 256) return false;
        int pm, pn; tile_order(L, 32, 8, pm, pn); u.pm = pm; u.pn = pn; u.nt = 88; u.kind = K_X2;
        u.A = ws + WS_ACT + (size_t)pm * 256 * DFF * 2; u.B = wl + WO_D + (size_t)pn * 256 * DFF * 2;
        return true; }
    }
}

__device__ __forceinline__ void epilogue(const f32x4 (&acc)[2][2][4][2], const Unit& u, const Frame& F, int l, int wr, int wc, int fr, int fq) {
    size_t wso = 0; asm volatile("" : "+s"(wso));
    unsigned char* ws = F.ws + wso;
    int rt0 = wr * 64 + fr;
    int c8 = wc * 64 + fq * 8;
    asm volatile("" : "+v"(rt0), "+v"(c8));
    switch (u.kind) {
    case K_Q: case K_K: {
        const bool isq = (u.kind == K_Q);
        const float* gam = (isq ? FIN(IN_QG) : FIN(IN_KG)) + l * 64; const float gs = isq ? 0.125f : 1.0f;
        f32x4 gv[2][2];
#pragma unroll
        for (int bj = 0; bj < 2; ++bj)
#pragma unroll
            for (int n = 0; n < 2; ++n) gv[bj][n] = ldg_f4(gam + 32 * bj + 8 * fq + 4 * n) * gs;
        bf16_t* dst = (bf16_t*)(ws + (isq ? WS_Q : WS_K)) + (size_t)(u.pm * 256 + rt0) * 1024 + u.ocol + c8;
        float* dk = F.out + OUT_NEWK + ((size_t)(u.pm * 2 + l) * 256 + rt0) * 1024 + u.ocol + c8;
        const bool wk = (!isq) && (u.pm < 16);
#pragma unroll
        for (int ai = 0; ai < 2; ++ai)
#pragma unroll
            for (int m = 0; m < 4; ++m) {
                float ss = 0.f;
#pragma unroll
                for (int bj = 0; bj < 2; ++bj)
#pragma unroll
                    for (int n = 0; n < 2; ++n) { const f32x4 v = acc[ai][bj][m][n]; ss += (v[0] * v[0] + v[1] * v[1]) + (v[2] * v[2] + v[3] * v[3]); }
                ss += __shfl_xor(ss, 16); ss += __shfl_xor(ss, 32);
                const float rs = __builtin_amdgcn_rsqf(ss * (1.0f / 64.0f) + EPS);
                const size_t ro = (size_t)(ai * 128 + m * 16) * 1024;
#pragma unroll
                for (int bj = 0; bj < 2; ++bj) {
                    const f32x4 o0 = acc[ai][bj][m][0] * rs * gv[bj][0], o1 = acc[ai][bj][m][1] * rs * gv[bj][1];
                    u32x4 w; w.x = cvt_pk_bf16(o0[0], o0[1]); w.y = cvt_pk_bf16(o0[2], o0[3]); w.z = cvt_pk_bf16(o1[0], o1[1]); w.w = cvt_pk_bf16(o1[2], o1[3]);
                    stg_u4(dst + ro + 32 * bj, w);
                    if (wk) { stg_f4(dk + ro + 32 * bj, o0); stg_f4(dk + ro + 32 * bj + 4, o1); }
                }
            }
        break; }
    case K_V: {
        bf16_t* dst = (bf16_t*)(ws + WS_V) + (size_t)(u.pm * 256 + rt0) * 1024 + u.ocol + c8;
        float* dv = F.out + OUT_NEWV + ((size_t)(u.pm * 2 + l) * 256 + rt0) * 1024 + u.ocol + c8;
        const bool wv = (u.pm < 16);
#pragma unroll
        for (int ai = 0; ai < 2; ++ai)
#pragma unroll
            for (int m = 0; m < 4; ++m) { const size_t ro = (size_t)(ai * 128 + m * 16) * 1024;
#pragma unroll
                for (int bj = 0; bj < 2; ++bj) { const f32x4 o0 = acc[ai][bj][m][0], o1 = acc[ai][bj][m][1];
                    u32x4 w; w.x = cvt_pk_bf16(o0[0], o0[1]); w.y = cvt_pk_bf16(o0[2], o0[3]); w.z = cvt_pk_bf16(o1[0], o1[1]); w.w = cvt_pk_bf16(o1[2], o1[3]);
                    stg_u4(dst + ro + 32 * bj, w);
                    if (wv) { stg_f4(dv + ro + 32 * bj, o0); stg_f4(dv + ro + 32 * bj + 4, o1); } } }
        break; }
    case K_UT: {
        const int pm = u.pm; bf16_t* base;
        if (pm >= 16) base = (bf16_t*)(ws + WS_UTS) + ((size_t)((pm - 16) >> 2) * 1024 + u.ocol) * 1024 + ((pm - 16) & 3) * 256;
        else base = (bf16_t*)(ws + WS_UTP) + ((size_t)pm * 1024 + u.ocol) * 1024;
        base += (size_t)rt0 * 1024 + wc * 32 + fq * 4;
#pragma unroll
        for (int ai = 0; ai < 2; ++ai)
#pragma unroll
            for (int m = 0; m < 4; ++m) { bf16_t* rp = base + (size_t)(ai * 128 + m * 16) * 1024;
#pragma unroll
                for (int bj = 0; bj < 2; ++bj)
#pragma unroll
                    for (int n = 0; n < 2; ++n) { const f32x4 v = acc[ai][bj][m][n]; u32x2 w; w.x = cvt_pk_bf16(v[0], v[1]); w.y = cvt_pk_bf16(v[2], v[3]); stg_u2(rp + 128 * bj + 16 * n, w); } }
        break; }
    case K_G: {
        unsigned short* dst = (unsigned short*)(ws + WS_G) + (size_t)(u.pm * 256 + rt0) * 4096 + u.ocol + c8;
#pragma unroll
        for (int ai = 0; ai < 2; ++ai)
#pragma unroll
            for (int m = 0; m < 4; ++m) { const size_t ro = (size_t)(ai * 128 + m * 16) * 4096;
#pragma unroll
                for (int bj = 0; bj < 2; ++bj) { const f32x4 o0 = acc[ai][bj][m][0], o1 = acc[ai][bj][m][1];
                    u32x4 w; w.x = pk_h16(sigmoidf_(o0[0]), sigmoidf_(o0[1])); w.y = pk_h16(sigmoidf_(o0[2]), sigmoidf_(o0[3])); w.z = pk_h16(sigmoidf_(o1[0]), sigmoidf_(o1[1])); w.w = pk_h16(sigmoidf_(o1[2]), sigmoidf_(o1[3]));
                    stg_u4(dst + ro + 32 * bj, w); } }
        break; }
    case K_Y: case K_F: {
        const bool isy = (u.kind == K_Y);
        bf16_t* dst = isy ? (bf16_t*)(ws + WS_Y) + ((size_t)(u.pn >> 1) * NTOK + u.orow + rt0) * 1024 + (u.pn & 1) * 512 + u.ocol * 256 + c8
                          : (bf16_t*)(ws + WS_F) + (size_t)(u.orow + rt0) * 1024 + u.ocol + c8;
#pragma unroll
        for (int ai = 0; ai < 2; ++ai)
#pragma unroll
            for (int m = 0; m < 4; ++m) { const size_t ro = (size_t)(ai * 128 + m * 16) * 1024;
#pragma unroll
                for (int bj = 0; bj < 2; ++bj) { const f32x4 o0 = acc[ai][bj][m][0], o1 = acc[ai][bj][m][1];
                    u32x4 w; w.x = cvt_pk_bf16(o0[0], o0[1]); w.y = cvt_pk_bf16(o0[2], o0[3]); w.z = cvt_pk_bf16(o1[0], o1[1]); w.w = cvt_pk_bf16(o1[2], o1[3]);
                    stg_u4(dst + ro + 32 * bj, w); } }
        if (isy) asm volatile("s_waitcnt vmcnt(0)" ::: "memory");
        break; }
    case K_MIXA: case K_MIXB: {
        const unsigned short* gb = (const unsigned short*)(ws + WS_G) + (size_t)(u.pm * 256 + rt0) * 4096 + u.pn * 256 + c8 + 2048;
        bf16_t* dst = (bf16_t*)(ws + WS_MIX) + (size_t)(u.pm * 256 + rt0) * DM + u.pn * 256 + c8;
        u32x4 gg[2][2];
#define MIXB_LOAD(slot, g) do { const size_t rg_ = (size_t)(((g) >> 2) * 128 + ((g) & 3) * 16) * 4096; _Pragma("unroll") for (int bj = 0; bj < 2; ++bj) gg[slot][bj] = ldg_u4(gb + rg_ + 32 * bj); } while (0)
        MIXB_LOAD(0, 0);
#pragma unroll
        for (int g = 0; g < 8; ++g) { const int ai = g >> 2, m = g & 3, sl = g & 1; const size_t ro = (size_t)(ai * 128 + m * 16) * DM;
            if (g < 7) MIXB_LOAD((g + 1) & 1, g + 1);
#pragma unroll
            for (int bj = 0; bj < 2; ++bj) {
                const u32x4 q = gg[sl][bj];
                const f32x4 g0 = (f32x4){fmaxf(h16_lo(q.x), 1e-30f), fmaxf(h16_hi(q.x), 1e-30f), fmaxf(h16_lo(q.y), 1e-30f), fmaxf(h16_hi(q.y), 1e-30f)}, g1 = (f32x4){fmaxf(h16_lo(q.z), 1e-30f), fmaxf(h16_hi(q.z), 1e-30f), fmaxf(h16_lo(q.w), 1e-30f), fmaxf(h16_hi(q.w), 1e-30f)};
                const f32x4 o0 = acc[ai][bj][m][0] * g0, o1 = acc[ai][bj][m][1] * g1;
                u32x4 w; w.x = cvt_pk_bf16(o0[0], o0[1]); w.y = cvt_pk_bf16(o0[2], o0[3]); w.z = cvt_pk_bf16(o1[0], o1[1]); w.w = cvt_pk_bf16(o1[2], o1[3]);
                stg_u4(dst + ro + 32 * bj, w); } }
#undef MIXB_LOAD
        break; }
    case K_X1: case K_X2: {
        const bool is1 = (u.kind == K_X1);
        const int cond = cond_of_pm(u.pm);
        const float* gate = (const float*)(ws + WS_MOD) + (size_t)(l * 5 + cond) * NMOD + (is1 ? 2 : 5) * DM + u.pn * 256 + c8;
        f32x4 gv[2][2];
#pragma unroll
        for (int bj = 0; bj < 2; ++bj)
#pragma unroll
            for (int n = 0; n < 2; ++n) gv[bj][n] = ldg_f4(gate + 32 * bj + 4 * n);
        const size_t eo = (size_t)(u.pm * 256 + rt0) * DM + u.pn * 256 + c8;
        const float* src; float* dst;
        if (is1) { src = (l == 0) ? (u.pm < 16 ? FIN(IN_XP) : FIN(IN_XS) - (size_t)NPR * DM) : (const float*)(ws + WS_X2); dst = (float*)(ws + WS_X1); }
        else { src = (const float*)(ws + WS_X1); dst = (l == 0) ? (float*)(ws + WS_X2) : F.out; }
        src += eo; dst += eo;
        f32x4 xr[2][4];
#define XRES_LOAD(slot, g) do { const size_t ro_ = (size_t)(((g) >> 2) * 128 + ((g) & 3) * 16) * DM; \
            _Pragma("unroll") for (int bj = 0; bj < 2; ++bj) { xr[slot][2 * bj] = ldg_f4(src + ro_ + 32 * bj); xr[slot][2 * bj + 1] = ldg_f4(src + ro_ + 32 * bj + 4); } } while (0)
        XRES_LOAD(0, 0);
#pragma unroll
        for (int g = 0; g < 8; ++g) { const int ai = g >> 2, m = g & 3, sl = g & 1; const size_t ro = (size_t)(ai * 128 + m * 16) * DM;
            if (g < 7) XRES_LOAD((g + 1) & 1, g + 1);
#pragma unroll
            for (int bj = 0; bj < 2; ++bj)
#pragma unroll
                for (int n = 0; n < 2; ++n) stg_f4(dst + ro + 32 * bj + 4 * n, xr[sl][2 * bj + n] + gv[bj][n] * acc[ai][bj][m][n]); }
#undef XRES_LOAD
        break; }
    default: {
        bf16_t* dst = (bf16_t*)(ws + WS_ACT) + (size_t)(u.pm * 256 + rt0) * DFF + u.pn * 128 + wc * 32 + fq * 8;
#pragma unroll
        for (int ai = 0; ai < 2; ++ai)
#pragma unroll
            for (int m = 0; m < 4; ++m) { float o[8];
#pragma unroll
                for (int e = 0; e < 8; ++e) { const float a = acc[ai][0][m][e >> 2][e & 3], g = acc[ai][1][m][e >> 2][e & 3]; o[e] = a * g * sigmoidf_(g); }
                u32x4 w; w.x = cvt_pk_bf16(o[0], o[1]); w.y = cvt_pk_bf16(o[2], o[3]); w.z = cvt_pk_bf16(o[4], o[5]); w.w = cvt_pk_bf16(o[6], o[7]);
                stg_u4(dst + (size_t)(ai * 128 + m * 16) * DFF, w); }
        break; }
    }
}


__device__ __forceinline__ void mixa_scale(f32x4 (&acc)[2][2][4][2], const Unit& u, const Frame& F, int wr, int wc, int fr, int fq) {
    size_t wso = 0; asm volatile("" : "+s"(wso)); unsigned char* ws = F.ws + wso;
    int rt0 = wr * 64 + fr, c8 = wc * 64 + fq * 8; asm volatile("" : "+v"(rt0), "+v"(c8));
    const unsigned short* gb = (const unsigned short*)(ws + WS_G) + (size_t)(u.pm * 256 + rt0) * 4096 + u.pn * 256 + c8;
#pragma unroll
    for (int g = 0; g < 8; ++g) { const int ai = g >> 2, m = g & 3; const size_t rg = (size_t)(ai * 128 + m * 16) * 4096;
#pragma unroll
        for (int bj = 0; bj < 2; ++bj) { const u32x4 a = ldg_u4(gb + rg + 32 * bj), f = ldg_u4(gb + rg + 2048 + 32 * bj);
            const float an[8] = {h16_lo(a.x), h16_hi(a.x), h16_lo(a.y), h16_hi(a.y), h16_lo(a.z), h16_hi(a.z), h16_lo(a.w), h16_hi(a.w)};
            const float fn_[8] = {h16_lo(f.x), h16_hi(f.x), h16_lo(f.y), h16_hi(f.y), h16_lo(f.z), h16_hi(f.z), h16_lo(f.w), h16_hi(f.w)};
#pragma unroll
            for (int e = 0; e < 8; ++e) acc[ai][bj][m][e >> 2][e & 3] *= an[e] * frcp(fmaxf(fn_[e], 1e-30f)); } }
}

__device__ __forceinline__ void fused_resnorm_epilogue(f32x4 (&acc)[2][2][4][2], const Unit& u, const Frame& F, int l, bool is1) {
    unsigned char* ws = F.ws;
    int tid = FTID(F); asm volatile("" : "+v"(tid));
    const int lane = tid & 63, fr = lane & 15, fq = lane >> 4, wr = F.wave >> 2, wc = F.wave & 3;
    const int rt0 = wr * 64 + fr, c8 = wc * 64 + fq * 8, cond = cond_of_pm(u.pm), use = is1 ? 2 * l : 2 * l + 1;
    const size_t tile_el = (size_t)u.pm * 256 * DM + u.pn * 256;
    const unsigned lo4 = (unsigned)(rt0 * DM + c8) * 4u, lo2 = (unsigned)(rt0 * DM + c8) * 2u;
    const char* srcb; char* dstb;
    if (is1) { srcb = (const char*)((l == 0) ? (u.pm < 16 ? FIN(IN_XP) : FIN(IN_XS) - (size_t)NPR * DM) : (const float*)(ws + WS_X2)); dstb = (char*)(ws + WS_X1); }
    else { srcb = (const char*)(ws + WS_X1); dstb = (char*)(ws + WS_X2); }
    srcb += tile_el * 4; dstb += tile_el * 4;
    const float* gate = (const float*)(ws + WS_MOD) + (size_t)(l * 5 + cond) * NMOD + (is1 ? 2 : 5) * DM + u.pn * 256 + c8;
#define GRP_OFF(g, elsz) ((size_t)((((g) >> 2) * 128 + ((g) & 3) * 16) * DM) * (elsz))
    float ssq[8];
#pragma unroll
    for (int g = 0; g < 8; ++g) ssq[g] = 0.f;
#pragma unroll
    for (int bj = 0; bj < 2; ++bj) {
        f32x4 xr[2][2], gv[2];
        gv[0] = ldg_f4(gate + 32 * bj); gv[1] = ldg_f4(gate + 32 * bj + 4);
        xr[0][0] = ldg_f4(srcb + (lo4 + 128u * bj)); xr[0][1] = ldg_f4(srcb + (lo4 + 128u * bj + 16u));
#pragma unroll
        for (int g = 0; g < 8; ++g) { const int ai = g >> 2, m = g & 3, sl = g & 1;
            if (g < 7) { xr[sl ^ 1][0] = ldg_f4(srcb + GRP_OFF(g + 1, 4) + (lo4 + 128u * bj)); xr[sl ^ 1][1] = ldg_f4(srcb + GRP_OFF(g + 1, 4) + (lo4 + 128u * bj + 16u)); }
#pragma unroll
            for (int n = 0; n < 2; ++n) { const f32x4 xn = xr[sl][n] + gv[n] * acc[ai][bj][m][n]; stg_f4(dstb + GRP_OFF(g, 4) + (lo4 + 128u * bj + 16u * n), xn); acc[ai][bj][m][n] = xn;
                ssq[g] += (xn[0] * xn[0] + xn[1] * xn[1]) + (xn[2] * xn[2] + xn[3] * xn[3]); }
            asm volatile("" ::: "memory"); }
    }
    { float* part = (float*)(ws + WS_PART) + ((size_t)u.pm * 256 + rt0) * 32 + u.pn * 4 + wc;
#pragma unroll
      for (int g = 0; g < 8; ++g) { float ss = ssq[g]; ss += __shfl_xor(ss, 16); ss += __shfl_xor(ss, 32);
          __hip_atomic_store(part + (size_t)((g >> 2) * 128 + (g & 3) * 16) * 32, ss, __ATOMIC_RELAXED, __HIP_MEMORY_SCOPE_AGENT); } }
    asm volatile("s_waitcnt vmcnt(0)" ::: "memory");
    unsigned* cnt = (unsigned*)(ws + WS_CTL + 65536) + (size_t)(use * 32 + u.pm) * 64;
    if (lane == 0) __hip_atomic_fetch_add(cnt, 1u, __ATOMIC_RELAXED, __HIP_MEMORY_SCOPE_AGENT);
    if (F.wave == 0) { unsigned sp = 0u;
        while ((unsigned)__builtin_amdgcn_readfirstlane(__hip_atomic_load(cnt, __ATOMIC_RELAXED, __HIP_MEMORY_SCOPE_AGENT)) < 64u) { __builtin_amdgcn_s_sleep(2); if (++sp > (1u << 19)) break; }
        __builtin_amdgcn_fence(__ATOMIC_ACQUIRE, "agent");
        asm volatile("s_waitcnt vmcnt(0)" ::: "memory"); }
    asm volatile("s_waitcnt vmcnt(0) lgkmcnt(0)" ::: "memory"); __builtin_amdgcn_s_barrier(); asm volatile("" ::: "memory");
    LAS float* S = (LAS float*)(F.lds);
    { const int row = F.wave * 32 + (lane & 31), half = lane >> 5; const float* pr = (const float*)(ws + WS_PART) + ((size_t)u.pm * 256 + row) * 32 + half * 16;
      float t = 0.f;
#pragma unroll
      for (int k = 0; k < 8; ++k) { const unsigned long long v2 = __hip_atomic_load((const unsigned long long*)pr + k, __ATOMIC_RELAXED, __HIP_MEMORY_SCOPE_AGENT);
          t += __uint_as_float((unsigned)v2) + __uint_as_float((unsigned)(v2 >> 32)); }
      t += __shfl_xor(t, 32);
      if (half == 0) S[row] = __builtin_amdgcn_rsqf(t * (1.0f / DM) + EPS); }
    asm volatile("s_waitcnt lgkmcnt(0)" ::: "memory"); __builtin_amdgcn_s_barrier(); asm volatile("" ::: "memory");
    const int ln = is1 ? l : l + 1;
    const float* gam = (is1 ? FIN(IN_N2) : FIN(IN_N1)) + ln * DM + u.pn * 256 + c8;
    const float* modp = (const float*)(ws + WS_MOD) + (size_t)(ln * 5 + cond) * NMOD + (is1 ? 3 : 0) * DM + u.pn * 256 + c8;
    char* hdb = (char*)(ws + WS_H) + tile_el * 2;
    float rs8[8];
#pragma unroll
    for (int g = 0; g < 8; ++g) rs8[g] = S[(g >> 2) * 128 + wr * 64 + (g & 3) * 16 + fr];
#pragma unroll
    for (int bj = 0; bj < 2; ++bj) {
        f32x4 mul[2], add[2];
#pragma unroll
        for (int n = 0; n < 2; ++n) { mul[n] = ldg_f4(gam + 32 * bj + 4 * n) * (ldg_f4(modp + DM + 32 * bj + 4 * n) + 1.0f); add[n] = ldg_f4(modp + 32 * bj + 4 * n); }
#pragma unroll
        for (int g = 0; g < 8; ++g) { const int ai = g >> 2, m = g & 3;
            const f32x4 o0 = acc[ai][bj][m][0] * rs8[g] * mul[0] + add[0], o1 = acc[ai][bj][m][1] * rs8[g] * mul[1] + add[1];
            u32x4 w; w.x = cvt_pk_bf16(o0[0], o0[1]); w.y = cvt_pk_bf16(o0[2], o0[3]); w.z = cvt_pk_bf16(o1[0], o1[1]); w.w = cvt_pk_bf16(o1[2], o1[3]);
            stg_u4(hdb + GRP_OFF(g, 2) + (lo2 + 64u * bj), w); }
    }
#undef GRP_OFF
}

__device__ __forceinline__ void gemm_phase(const Frame& F, int gt, int l, int Geff) {
    LAS unsigned char* lds = F.lds;
    int tid = FTID(F); asm volatile("" : "+v"(tid));
    const int wid = F.wave, lane = tid & 63, wr = wid >> 2, wc = wid & 3, fr = lane & 15, fq = lane >> 4;
    int lda, ldb;
    switch (gt) { case GT_G1: case GT_G3: case GT_G4: case GT_G4M: lda = 2048; ldb = 2048; break; case GT_DFTPOS: case GT_G2: lda = 1024; ldb = 1024; break; default: lda = DFF; ldb = DFF; break; }
    unsigned voffA[2], voffB[2];
#pragma unroll
    for (int i = 0; i < 2; ++i) { int R, C; stage_rc(tid * 16 + i * 8192, R, C); voffA[i] = (unsigned)(R * lda + C) * 2u; voffB[i] = (unsigned)(R * ldb + C) * 2u; }
    const size_t kstep = (size_t)(BK * 2);
    const size_t hstepA = (size_t)HALF * lda * 2, hstepB = (size_t)HALF * ldb * 2;
    const unsigned ldsw = (unsigned)wid * 1024u;
    const int aoff = lds_byte(wr * 64 + fr, fq * 8), boff = lds_byte(wc * 32 + fr, fq * 8);
#define PG8_SA(b, h) (((b) * 2 + (h)) * HTB)
#define PG8_SB(b, h) ((4 + (b) * 2 + (h)) * HTB)
#define PG8_STAGE(bufoff, gbase, voff) do { _Pragma("unroll") for (int _i = 0; _i < 2; ++_i) \
        __builtin_amdgcn_global_load_lds((const GAS unsigned*)((gbase) + (voff)[_i]), (LAS unsigned*)(lds + (bufoff) + ldsw + _i * 8192), 16, 0, 0); } while (0)
#define PG8_LDA(dst, b, h) do { _Pragma("unroll") for (int m = 0; m < 4; ++m) _Pragma("unroll") for (int k = 0; k < 2; ++k) dst[m][k] = *(const LAS bf16x8*)(lds + PG8_SA(b, h) + aoff + m * 2048 + k * 1024); } while (0)
#define PG8_LDB(dst, b, h) do { _Pragma("unroll") for (int n = 0; n < 2; ++n) _Pragma("unroll") for (int k = 0; k < 2; ++k) dst[n][k] = *(const LAS bf16x8*)(lds + PG8_SB(b, h) + boff + n * 2048 + k * 1024); } while (0)
#define PG8_MMA(ai, bj, At, Bt) do { __builtin_amdgcn_s_setprio(1); _Pragma("unroll") for (int m = 0; m < 4; ++m) _Pragma("unroll") for (int n = 0; n < 2; ++n) _Pragma("unroll") for (int k = 0; k < 2; ++k) \
        acc[ai][bj][m][n] = __builtin_amdgcn_mfma_f32_16x16x32_bf16(Bt[n][k], At[m][k], acc[ai][bj][m][n], 0, 0, 0); __builtin_amdgcn_s_setprio(0); } while (0)
#define PG8_WAIT_V(n) asm volatile("s_waitcnt vmcnt(" #n ")" ::: "memory")
#define PG8_WAIT_L(n) asm volatile("s_waitcnt lgkmcnt(" #n ")" ::: "memory")
#define PG8_BAR __builtin_amdgcn_s_barrier()
#define PG8_SCHED __builtin_amdgcn_sched_barrier(0)
    Unit cur, nxt; int ui = 0;
    int g256 = F.G; asm volatile("" : "+s"(g256));
    const bool fused = (g256 == 256) && (gt == GT_G3 || (gt == GT_G5 && l == 0));
    if (!get_unit(F, gt, l, 0, Geff, cur)) return;
    f32x4 acc[2][2][4][2];
#pragma unroll
    for (int a = 0; a < 2; ++a)
#pragma unroll
        for (int b = 0; b < 2; ++b)
#pragma unroll
            for (int m = 0; m < 4; ++m)
#pragma unroll
                for (int n = 0; n < 2; ++n) acc[a][b][m][n] = (f32x4){0.f, 0.f, 0.f, 0.f};
    bf16x8 At[4][2], B0[2][2], B1[2][2];
    gcptr cA = cur.A; gcptr cB = cur.B;
    if constexpr (GEMM_SP2) {
        PG8_STAGE(PG8_SB(0, 0), cB, voffB); PG8_STAGE(PG8_SB(0, 1), cB + hstepB, voffB); PG8_STAGE(PG8_SA(0, 0), cA, voffA); PG8_STAGE(PG8_SA(0, 1), cA + hstepA, voffA);
        if (wr == 1) PG8_BAR;
        PG8_WAIT_V(2); PG8_BAR;
        PG8_STAGE(PG8_SB(1, 0), cB + kstep, voffB); PG8_STAGE(PG8_SA(1, 0), cA + kstep, voffA); PG8_STAGE(PG8_SB(1, 1), cB + hstepB + kstep, voffB);
        PG8_WAIT_V(6); PG8_BAR;
    } else {
    PG8_STAGE(PG8_SB(0, 0), cB, voffB); PG8_STAGE(PG8_SA(0, 0), cA, voffA); PG8_STAGE(PG8_SB(0, 1), cB + hstepB, voffB); PG8_STAGE(PG8_SA(0, 1), cA + hstepA, voffA);
    if (wr == 1) PG8_BAR;
    PG8_WAIT_V(4); PG8_BAR;
    PG8_STAGE(PG8_SB(1, 0), cB + kstep, voffB); PG8_STAGE(PG8_SA(1, 0), cA + kstep, voffA); PG8_STAGE(PG8_SB(1, 1), cB + hstepB + kstep, voffB);
    PG8_WAIT_V(6); PG8_BAR;
    }
    for (;;) {
        const bool has_next = get_unit(F, gt, l, ui + 1, Geff, nxt);
        gcptr nA = has_next ? nxt.A : cA; gcptr nB = has_next ? nxt.B : cB;
        const int nt = cur.nt;
        for (int t = 0; t < nt; t += 2) {
            const bool last = (t == nt - 2);
            gcptr a1 = cA + (size_t)(t + 1) * kstep;
            gcptr a2 = last ? nA : cA + (size_t)(t + 2) * kstep; gcptr b2 = last ? nB : cB + (size_t)(t + 2) * kstep;
            gcptr a3 = a2 + kstep; gcptr b3 = b2 + kstep;
            if constexpr (GEMM_SP2) {
            PG8_LDB(B0, 0, 0); PG8_LDB(B1, 0, 1); PG8_SCHED; PG8_LDA(At, 0, 0); PG8_STAGE(PG8_SA(1, 1), a1 + hstepA, voffA);
            PG8_WAIT_V(8); PG8_WAIT_L(0); PG8_BAR; PG8_MMA(0, 0, At, B0); PG8_MMA(0, 1, At, B1); PG8_BAR; PG8_SCHED;
            PG8_LDA(At, 0, 1); PG8_STAGE(PG8_SB(0, 0), b2, voffB); PG8_STAGE(PG8_SB(0, 1), b2 + hstepB, voffB); PG8_STAGE(PG8_SA(0, 0), a2, voffA);
            PG8_WAIT_V(8); PG8_WAIT_L(0); PG8_BAR; PG8_MMA(1, 0, At, B0); PG8_MMA(1, 1, At, B1); PG8_BAR; PG8_SCHED;
            PG8_LDB(B0, 1, 0); PG8_LDB(B1, 1, 1); PG8_SCHED; PG8_LDA(At, 1, 0); PG8_STAGE(PG8_SA(0, 1), a2 + hstepA, voffA);
            PG8_WAIT_V(8); PG8_WAIT_L(0); PG8_BAR; PG8_MMA(0, 0, At, B0); PG8_MMA(0, 1, At, B1); PG8_BAR; PG8_SCHED;
            PG8_LDA(At, 1, 1); PG8_STAGE(PG8_SB(1, 0), b3, voffB); PG8_STAGE(PG8_SB(1, 1), b3 + hstepB, voffB); PG8_STAGE(PG8_SA(1, 0), a3, voffA);
            PG8_WAIT_V(8); PG8_WAIT_L(0); PG8_BAR; PG8_MMA(1, 0, At, B0); PG8_MMA(1, 1, At, B1); PG8_BAR; PG8_SCHED;
            } else {
            PG8_LDB(B0, 0, 0); PG8_SCHED; PG8_LDA(At, 0, 0); PG8_STAGE(PG8_SA(1, 1), a1 + hstepA, voffA);
            PG8_WAIT_L(8); PG8_BAR; PG8_WAIT_L(0); PG8_MMA(0, 0, At, B0); PG8_BAR; PG8_SCHED;
            PG8_LDB(B1, 0, 1); PG8_STAGE(PG8_SB(0, 0), b2, voffB);
            PG8_BAR; PG8_WAIT_L(0); PG8_MMA(0, 1, At, B1); PG8_BAR;
            PG8_LDA(At, 0, 1); PG8_STAGE(PG8_SA(0, 0), a2, voffA);
            PG8_BAR; PG8_WAIT_L(0); PG8_MMA(1, 0, At, B0); PG8_BAR; PG8_SCHED;
            PG8_STAGE(PG8_SB(0, 1), b2 + hstepB, voffB);
            PG8_WAIT_V(6); PG8_BAR; PG8_MMA(1, 1, At, B1); PG8_BAR;
            PG8_LDB(B0, 1, 0); PG8_SCHED; PG8_LDA(At, 1, 0); PG8_STAGE(PG8_SA(0, 1), a2 + hstepA, voffA);
            PG8_WAIT_L(8); PG8_BAR; PG8_WAIT_L(0); PG8_MMA(0, 0, At, B0); PG8_BAR; PG8_SCHED;
            PG8_LDB(B1, 1, 1); PG8_STAGE(PG8_SB(1, 0), b3, voffB);
            PG8_BAR; PG8_WAIT_L(0); PG8_MMA(0, 1, At, B1); PG8_BAR;
            PG8_LDA(At, 1, 1); PG8_STAGE(PG8_SA(1, 0), a3, voffA);
            PG8_BAR; PG8_WAIT_L(0); PG8_MMA(1, 0, At, B0); PG8_BAR; PG8_SCHED;
            PG8_STAGE(PG8_SB(1, 1), b3 + hstepB, voffB);
            PG8_WAIT_V(6); PG8_BAR; PG8_MMA(1, 1, At, B1); PG8_BAR;
            }
        }
        if constexpr (GEMM_ALIGN_EPI) { if (wr == 0) PG8_BAR; }
        if (cur.kind == K_MIXA) mixa_scale(acc, cur, F, wr, wc, fr, fq);
        else if (!fused) epilogue(acc, cur, F, l, wr, wc, fr, fq);
        if (!has_next) break;
        if (cur.kind != K_MIXA) {
#pragma unroll
            for (int a = 0; a < 2; ++a)
#pragma unroll
                for (int b = 0; b < 2; ++b)
#pragma unroll
                    for (int m = 0; m < 4; ++m)
#pragma unroll
                        for (int n = 0; n < 2; ++n) acc[a][b][m][n] = (f32x4){0.f, 0.f, 0.f, 0.f};
        }
        cur = nxt; cA = nA; cB = nB; ++ui;
        if constexpr (GEMM_ALIGN_EPI) { if (wr == 1) PG8_BAR; }
    }
    PG8_WAIT_V(0);
    if constexpr (!GEMM_ALIGN_EPI) { if (wr == 0) PG8_BAR; }
    PG8_BAR;
    if (fused) fused_resnorm_epilogue(acc, cur, F, l, gt == GT_G3);
}

__device__ __forceinline__ void gemm_half_g4(const Frame& F, int l) {
    LAS unsigned char* lds = F.lds;
    int tid = FTID(F); asm volatile("" : "+v"(tid));
    const int wid = F.wave, lane = tid & 63, wr = wid >> 2, wc = wid & 3, fr = lane & 15, fq = lane >> 4;
    constexpr int lda = 2048, ldb = 2048, nt = 32;
    unsigned voffA[2], voffB[2];
#pragma unroll
    for (int i = 0; i < 2; ++i) { int R, C; stage_rc(tid * 16 + i * 8192, R, C); voffA[i] = (unsigned)(R * lda + C) * 2u; voffB[i] = (unsigned)(R * ldb + C) * 2u; }
    const size_t kstep = (size_t)(BK * 2), hstepB = (size_t)HALF * ldb * 2;
    const unsigned ldsw = (unsigned)wid * 1024u;
    const int aoff = lds_byte(wr * 64 + fr, fq * 8), boff = lds_byte(wc * 32 + fr, fq * 8);
    const int c = F.bid, hA = c & 1; int pm, pn; tile_order(1280 + (c >> 1), 32, 44, pm, pn);
    gcptr cA = (gcptr)F.ws + WS_H + (size_t)(pm * 256 + hA * 128) * DM * 2; gcptr cB = (gcptr)F.ws + WS_W + (size_t)l * W_LAYER + WO_GU + (size_t)pn * 256 * DM * 2;
    f32x4 acc[1][2][4][2];
#pragma unroll
    for (int b = 0; b < 2; ++b)
#pragma unroll
        for (int m = 0; m < 4; ++m)
#pragma unroll
            for (int n = 0; n < 2; ++n) acc[0][b][m][n] = (f32x4){0.f, 0.f, 0.f, 0.f};
    bf16x8 At[4][2], B0[2][2], B1[2][2];
    PG8_STAGE(PG8_SB(0, 0), cB, voffB); PG8_STAGE(PG8_SA(0, 0), cA, voffA); PG8_STAGE(PG8_SB(0, 1), cB + hstepB, voffB);
    if (wr == 1) PG8_BAR;
    PG8_WAIT_V(2); PG8_BAR;
    PG8_STAGE(PG8_SB(1, 0), cB + kstep, voffB); PG8_STAGE(PG8_SA(1, 0), cA + kstep, voffA);
    PG8_WAIT_V(6); PG8_BAR;
    for (int t = 0; t < nt; t += 2) {
        const int t2 = (t + 2 < nt) ? t + 2 : nt - 1, t3 = (t + 3 < nt) ? t + 3 : nt - 1;
        gcptr b1 = cB + (size_t)(t + 1) * kstep; gcptr a2 = cA + (size_t)t2 * kstep; gcptr b2 = cB + (size_t)t2 * kstep; gcptr a3 = cA + (size_t)t3 * kstep; gcptr b3 = cB + (size_t)t3 * kstep;
        PG8_LDB(B0, 0, 0); PG8_SCHED; PG8_LDA(At, 0, 0); PG8_STAGE(PG8_SB(1, 1), b1 + hstepB, voffB);
        PG8_WAIT_V(6); PG8_WAIT_L(0); PG8_BAR; PG8_MMA(0, 0, At, B0); PG8_BAR; PG8_SCHED;
        PG8_LDB(B1, 0, 1); PG8_STAGE(PG8_SB(0, 0), b2, voffB); PG8_STAGE(PG8_SA(0, 0), a2, voffA);
        PG8_WAIT_V(6); PG8_WAIT_L(0); PG8_BAR; PG8_MMA(0, 1, At, B1); PG8_BAR; PG8_SCHED;
        PG8_LDB(B0, 1, 0); PG8_SCHED; PG8_LDA(At, 1, 0); PG8_STAGE(PG8_SB(0, 1), b2 + hstepB, voffB);
        PG8_WAIT_V(6); PG8_WAIT_L(0); PG8_BAR; PG8_MMA(0, 0, At, B0); PG8_BAR; PG8_SCHED;
        PG8_LDB(B1, 1, 1); PG8_STAGE(PG8_SB(1, 0), b3, voffB); PG8_STAGE(PG8_SA(1, 0), a3, voffA);
        PG8_WAIT_V(6); PG8_WAIT_L(0); PG8_BAR; PG8_MMA(0, 1, At, B1); PG8_BAR; PG8_SCHED;
    }
    if (wr == 0) PG8_BAR;
    {
        int rt0 = wr * 64 + fr; asm volatile("" : "+v"(rt0));
        bf16_t* dst = (bf16_t*)(F.ws + WS_ACT) + (size_t)(pm * 256 + hA * 128 + rt0) * DFF + pn * 128 + wc * 32 + fq * 8;
#pragma unroll
        for (int m = 0; m < 4; ++m) { float o[8];
#pragma unroll
            for (int e = 0; e < 8; ++e) { const float a = acc[0][0][m][e >> 2][e & 3], g = acc[0][1][m][e >> 2][e & 3]; o[e] = a * g * sigmoidf_(g); }
            u32x4 w; w.x = cvt_pk_bf16(o[0], o[1]); w.y = cvt_pk_bf16(o[2], o[3]); w.z = cvt_pk_bf16(o[4], o[5]); w.w = cvt_pk_bf16(o[6], o[7]);
            stg_u4(dst + (size_t)(m * 16) * DFF, w); }
    }
    PG8_WAIT_V(0);
    PG8_BAR;
}
#undef PG8_SA
#undef PG8_SB
#undef PG8_STAGE
#undef PG8_LDA
#undef PG8_LDB
#undef PG8_MMA
#undef PG8_WAIT_V
#undef PG8_WAIT_L
#undef PG8_BAR
#undef PG8_SCHED

__device__ __forceinline__ int dst_row_std(int nn) { return (nn & ~255) + rho256(nn & 255); }
__device__ __forceinline__ int dst_row_glu(int nn) { const int half = nn >= DFF ? 1 : 0, cc = nn - half * DFF, pn = cc >> 7, L = cc & 127;
    return pn * 256 + 128 * half + 32 * (L >> 5) + 16 * ((L >> 2) & 1) + 4 * ((L >> 3) & 3) + (L & 3); }
constexpr int TR_SCR_BYTES = 64 * 65 * 4;
constexpr int I_IN = (DM / 64) * (4096 / 64), I_NA = (1024 / 64) * (DM / 64), I_O = (DM / 64) * (DM / 64), I_GU = (DM / 64) * (2 * DFF / 64), I_D = (DFF / 64) * (DM / 64);
constexpr int I_LAYER = 2 * I_IN + 2 * I_NA + I_O + I_GU + I_D, I_EARLY = 2 * I_IN + 2 * I_NA + I_O;
struct TItem { const float* W; bf16_t* WT; int K, N, mode, row_off, k0, n0; };
__device__ __forceinline__ TItem titem_decode(const Frame& F, int it) {
    TItem t; unsigned char* ws = F.ws; const int l = it / I_LAYER; int r = it % I_LAYER; unsigned char* wl = ws + WS_W + (size_t)l * W_LAYER;
    t.mode = 0; t.row_off = 0;
    if (r < I_IN) { t.W = FIN(IN_WIN) + (size_t)l * DM * 4096; t.K = DM; t.N = 4096; t.WT = (bf16_t*)(wl + WO_W1); }
    else if ((r -= I_IN) < I_IN) { t.W = FIN(IN_WGATE) + (size_t)l * DM * 4096; t.K = DM; t.N = 4096; t.WT = (bf16_t*)(wl + WO_W1); t.row_off = 4096; }
    else if ((r -= I_IN) < I_NA) { t.W = FIN(IN_WNA) + (size_t)l * 1024 * DM; t.K = 1024; t.N = DM; t.WT = (bf16_t*)(wl + WO_NA); }
    else if ((r -= I_NA) < I_NA) { t.W = FIN(IN_WFN) + (size_t)l * 1024 * DM; t.K = 1024; t.N = DM; t.WT = (bf16_t*)(wl + WO_FN); }
    else if ((r -= I_NA) < I_O) { t.W = FIN(IN_WO) + (size_t)l * DM * DM; t.K = DM; t.N = DM; t.WT = (bf16_t*)(wl + WO_O); }
    else if ((r -= I_O) < I_GU) { t.W = FIN(IN_WGU) + (size_t)l * DM * 2 * DFF; t.K = DM; t.N = 2 * DFF; t.WT = (bf16_t*)(wl + WO_GU); t.mode = 1; }
    else { r -= I_GU; t.W = FIN(IN_WD) + (size_t)l * DFF * DM; t.K = DFF; t.N = DM; t.WT = (bf16_t*)(wl + WO_D); }
    const int nblk = t.N / 64; t.k0 = 64 * (r / nblk); t.n0 = 64 * (r % nblk);
    return t;
}
__device__ __forceinline__ void titem_load(const TItem& t, int lane, f32x4 (&wv)[16]) {
    const float* wp = t.W + (size_t)(t.k0 + (lane >> 4)) * t.N + t.n0 + 4 * (lane & 15);
#pragma unroll
    for (int i = 0; i < 16; ++i) wv[i] = *(const f32x4*)(wp + (size_t)(4 * i) * t.N);
}
__device__ __forceinline__ void titem_finish(const TItem& t, int lane, const f32x4 (&wv)[16], LAS float* scr) {
    const int rr = lane >> 4, c4 = lane & 15;
#pragma unroll
    for (int i = 0; i < 16; ++i) { LAS float* d = scr + (4 * i + rr) * 65 + 4 * c4; d[0] = wv[i][0]; d[1] = wv[i][1]; d[2] = wv[i][2]; d[3] = wv[i][3]; }
    LDS_WAIT();
    const int c = lane & 7;
#pragma unroll
    for (int j = 0; j < 8; ++j) { const int n = (lane >> 3) + 8 * j; const LAS float* sp = scr + (8 * c) * 65 + n;
        u32x4 o; o.x = cvt_pk_bf16(sp[0 * 65], sp[1 * 65]); o.y = cvt_pk_bf16(sp[2 * 65], sp[3 * 65]); o.z = cvt_pk_bf16(sp[4 * 65], sp[5 * 65]); o.w = cvt_pk_bf16(sp[6 * 65], sp[7 * 65]);
        const int dr = t.row_off + (t.mode ? dst_row_glu(t.n0 + n) : dst_row_std(t.n0 + n));
        *(u32x4*)(t.WT + (size_t)dr * t.K + t.k0 + 8 * c) = o; }
    LDS_WAIT();
}
__device__ __forceinline__ void convert_range(const Frame& F, int lo, int hi, int gwv, int nwv) {
    int lane_ = FTID(F); asm volatile("" : "+v"(lane_)); lane_ &= 63;
    LAS float* scr = (LAS float*)(F.lds + F.wave * TR_SCR_BYTES);
    for (int it = lo + gwv; it < hi; it += 2 * nwv) {
        const int itb = it + nwv; const bool hb = itb < hi;
        const TItem a = titem_decode(F, it), b = titem_decode(F, hb ? itb : it);
        f32x4 va[16], vb[16];
        titem_load(a, lane_, va); titem_load(b, lane_, vb);
        titem_finish(a, lane_, va, scr);
        if (hb) titem_finish(b, lane_, vb, scr);
    }
}

__device__ __forceinline__ void p0_phase(const Frame& F) {
    unsigned char* ws = F.ws;
    int tid_ = FTID(F); asm volatile("" : "+v"(tid_)); const int lane_ = tid_ & 63;
    for (int item = F.bid; item < 256; item += F.G) {
        const int l = item >> 7, col0 = (item & 127) * 96;
        LAS float* S = (LAS float*)F.lds;
        LAS float* R = (LAS float*)(F.lds + 40960);
        for (int idx = tid_; idx < 5 * DM; idx += 512) { const int cnd = idx >> 11, k = idx & 2047; const float v = cnd < 4 ? FIN(IN_C)[cnd * DM + k] : FIN(IN_CCTX)[k]; S[idx] = v * sigmoidf_(v); }
        __syncthreads();
        const int sub = lane_ / 24, lc = lane_ - sub * 24, rsel = sub >= 1 ? 1 : 0;
        f32x4 a[5];
#pragma unroll
        for (int cnd = 0; cnd < 5; ++cnd) a[cnd] = (f32x4){0.f, 0.f, 0.f, 0.f};
        const float* wp = FIN(IN_WMOD) + ((size_t)l * DM + F.wave * 256 + rsel) * NMOD + col0 + 4 * lc;
        LAS const float* Sw = S + F.wave * 256 + rsel;
        for (int kk = 0; kk < 256; kk += 16) {
            f32x4 wv[8];
#pragma unroll
            for (int j = 0; j < 8; ++j) wv[j] = *(const f32x4*)(wp + (size_t)(kk + 2 * j) * NMOD);
#pragma unroll
            for (int j = 0; j < 8; ++j) {
#pragma unroll
                for (int cnd = 0; cnd < 5; ++cnd) { const float sv = Sw[cnd * DM + kk + 2 * j]; a[cnd] += wv[j] * sv; } }
        }
        if (sub < 2) {
#pragma unroll
            for (int cnd = 0; cnd < 5; ++cnd) *(LAS f32x4*)(R + ((F.wave * 2 + rsel) * 5 + cnd) * 96 + 4 * lc) = a[cnd]; }
        __syncthreads();
        for (int idx = tid_; idx < 5 * 96; idx += 512) { const int cnd = idx / 96, col = idx - cnd * 96; float sacc = FIN(IN_BMOD)[l * NMOD + col0 + col];
#pragma unroll
            for (int p = 0; p < 16; ++p) sacc += R[(p * 5 + cnd) * 96 + col];
            __hip_atomic_store((float*)(ws + WS_MOD) + (size_t)(l * 5 + cnd) * NMOD + col0 + col, sacc, __ATOMIC_RELAXED, __HIP_MEMORY_SCOPE_AGENT); }
        __syncthreads();
    }
    asm volatile("s_waitcnt vmcnt(0)" ::: "memory");
    __syncthreads();
    if (tid_ == 0) { unsigned nmine = 0; for (int item = F.bid; item < 43; item += F.G) ++nmine;
        if (nmine) (void)__hip_atomic_fetch_add((unsigned*)(ws + WS_CTL + 110592), nmine, __ATOMIC_RELAXED, __HIP_MEMORY_SCOPE_AGENT); }
    const int gw = F.bid * 8 + F.wave, NGW = F.G * 8;
    constexpr int C_CACHE = 4 * 2 * 256 * 1024 / 512, C_DT1024 = 2 * 1024 * 1024 / 512, C_DT256 = 2 * 256 * 256 / 512, C_DCT = 256 * 512 / 512;
    for (int ch = gw; ch < 2 * C_CACHE + C_DT1024 + C_DT256 + C_DCT; ch += NGW) {
        int r = ch; float v[8]; bf16_t* dst;
        if (r < 2 * C_CACHE) { const int which = r / C_CACHE; const size_t e = (size_t)(r % C_CACHE) * 512 + lane_ * 8; const float* src = (which ? FIN(IN_CV) : FIN(IN_CK)) + e;
            const f32x4 x0 = *(const f32x4*)src, x1 = *(const f32x4*)(src + 4); v[0] = x0[0]; v[1] = x0[1]; v[2] = x0[2]; v[3] = x0[3]; v[4] = x1[0]; v[5] = x1[1]; v[6] = x1[2]; v[7] = x1[3];
            dst = (bf16_t*)(ws + (which ? WS_CV : WS_CK)) + e; }
        else { r -= 2 * C_CACHE;
            if (r < C_DT1024) { const int e = r * 512 + lane_ * 8, cs = e >> 20, t = (e >> 10) & 1023, t0 = e & 1023;
#pragma unroll
                for (int j = 0; j < 8; ++j) { const int mm = (t * (t0 + j)) & 1023; const float x = (float)mm * (2.0f / 1024.0f); v[j] = (cs ? sinpif(x) : cospif(x)) * (1.0f / 32.0f); }
                dst = (bf16_t*)(ws + WS_DT1024) + e; }
            else { r -= C_DT1024;
                if (r < C_DT256) { const int e = r * 512 + lane_ * 8, cs = e >> 16, t = (e >> 8) & 255, t0 = e & 255;
#pragma unroll
                    for (int j = 0; j < 8; ++j) { const int mm = (t * (t0 + j)) & 255; const float x = (float)mm * (2.0f / 256.0f); v[j] = (cs ? sinpif(x) : cospif(x)) * (1.0f / 16.0f); }
                    dst = (bf16_t*)(ws + WS_DT256) + ((size_t)(cs * 256 + t) * 1024 + t0); }
                else { r -= C_DT256; const int e = r * 512 + lane_ * 8, row = e >> 9, col = e & 511, mlog = rho256_inv(row);
#pragma unroll
                    for (int j = 0; j < 8; ++j) { const int cc = col + j, cch = cc & 255, mm = (mlog * cch) & 255; const float x = (float)mm * (2.0f / 256.0f); v[j] = (cc < 256 ? cospif(x) : -sinpif(x)) * (1.0f / 16.0f); }
                    dst = (bf16_t*)(ws + WS_DCT) + (size_t)row * 1024 + col; } } }
        u32x4 o; o.x = cvt_pk_bf16(v[0], v[1]); o.y = cvt_pk_bf16(v[2], v[3]); o.z = cvt_pk_bf16(v[4], v[5]); o.w = cvt_pk_bf16(v[6], v[7]);
        *(u32x4*)dst = o;
    }
}

__device__ __forceinline__ float wave_sum(float v) {
#pragma unroll
    for (int o = 1; o < 64; o <<= 1) v += __shfl_xor(v, o);
    return v;
}
__device__ __forceinline__ void norm_phase(const Frame& F, int l, int which) {
    unsigned char* ws = F.ws;
    int lane = FTID(F); asm volatile("" : "+v"(lane)); lane &= 63;
    const int gw = F.bid * 8 + F.wave, NGW = F.G * 8;
    const float* gam = (which ? FIN(IN_N2) : FIN(IN_N1)) + l * DM;
    for (int row0 = gw; row0 < NTOK; row0 += 2 * NGW) {
        f32x4 v[2][8]; float ss[2] = {0.f, 0.f}; const int row1 = row0 + NGW;
#pragma unroll
        for (int r = 0; r < 2; ++r) { const int row = r ? row1 : row0; if (row < NTOK) {
            const float* xr;
            if (which) xr = (const float*)(ws + WS_X1) + (size_t)row * DM;
            else if (l == 0) xr = row < NPR ? FIN(IN_XP) + (size_t)row * DM : FIN(IN_XS) + (size_t)(row - NPR) * DM;
            else xr = (const float*)(ws + WS_X2) + (size_t)row * DM;
#pragma unroll
            for (int j = 0; j < 8; ++j) v[r][j] = *(const f32x4*)(xr + 256 * j + 4 * lane); } }
#pragma unroll
        for (int r = 0; r < 2; ++r) { const int row = r ? row1 : row0; if (row < NTOK) {
#pragma unroll
            for (int j = 0; j < 8; ++j) ss[r] += (v[r][j][0] * v[r][j][0] + v[r][j][1] * v[r][j][1]) + (v[r][j][2] * v[r][j][2] + v[r][j][3] * v[r][j][3]);
            const float rstd = __builtin_amdgcn_rsqf(wave_sum(ss[r]) * (1.0f / DM) + EPS);
            const int cond = row < NPR ? 4 : ((row - NPR) >> 10);
            const float* mod = (const float*)(ws + WS_MOD) + (size_t)(l * 5 + cond) * NMOD + (which ? 3 : 0) * DM;
            bf16_t* orow = (bf16_t*)(ws + WS_H) + (size_t)row * DM;
#pragma unroll
            for (int j = 0; j < 8; ++j) { const int c0 = 256 * j + 4 * lane;
                const f32x4 g = *(const f32x4*)(gam + c0), sh = *(const f32x4*)(mod + c0), sc = *(const f32x4*)(mod + DM + c0);
                const f32x4 o = v[r][j] * rstd * g * (sc + 1.0f) + sh;
                u32x2 w; w.x = cvt_pk_bf16(o[0], o[1]); w.y = cvt_pk_bf16(o[2], o[3]); *(u32x2*)(orow + c0) = w; } } }
    }
}

__device__ __forceinline__ unsigned vswz(int row, int byte) { return (unsigned)(row * 128 + ((((byte >> 4) ^ (((row >> 1) & 3) << 1)) << 4) | (byte & 15))); }
__device__ __forceinline__ s16x4 vtr(LAS const unsigned char* p) { return __builtin_bit_cast(s16x4, __builtin_amdgcn_ds_read_tr16_b64_v4i16((LAS v4i16_t*)p)); }

struct AttnState { float m, lsum; f32x4 o[4]; };

template <bool LOCAL, bool KLDS>
__device__ __forceinline__ void attn_chunk(AttnState& st, const bf16x8 (&qf)[2], const bf16_t* kp, const unsigned (&klds)[2], LAS const unsigned char* vbase, int vrow0, const unsigned (&voff)[4],
                                           LAS const float* rpbL, int qc, int wsq, int cs, int drbase, int fq) {
    f32x4 s[16];
#define KOFF(kb) (LOCAL ? ((size_t)(((kb) >> 1) * 64 + ((kb) & 1) * 16) * 1024) : ((size_t)(kb) * 16 * 1024))
#define VROW(kb) (LOCAL ? (vrow0 + ((kb) >> 1) * 64 + ((kb) & 1) * 16) : (vrow0 + (kb) * 16))
    {
        bf16x8 kf[16][2];
#pragma unroll
        for (int kb = 0; kb < 16; ++kb) {
            if (KLDS) { kf[kb][0] = *(LAS const bf16x8*)(vbase + klds[0] + kb * 2048); kf[kb][1] = *(LAS const bf16x8*)(vbase + klds[1] + kb * 2048); }
            else { const bf16_t* p = kp + KOFF(kb); kf[kb][0] = *(const bf16x8*)p; kf[kb][1] = *(const bf16x8*)(p + 32); } }
#pragma unroll
        for (int kb = 0; kb < 16; ++kb) { f32x4 z = (f32x4){0.f, 0.f, 0.f, 0.f};
            z = __builtin_amdgcn_mfma_f32_16x16x32_bf16(kf[kb][0], qf[0], z, 0, 0, 0);
            s[kb] = __builtin_amdgcn_mfma_f32_16x16x32_bf16(kf[kb][1], qf[1], z, 0, 0, 0); }
    }
    asm volatile("" ::: "memory");
    if (LOCAL) {
#pragma unroll
        for (int kb = 0; kb < 16; ++kb) {
            const int dr = drbase + (kb >> 1);
#pragma unroll
            for (int r = 0; r < 4; ++r) { const int kc = cs + 16 * (kb & 1) + 4 * fq + r; const int dc = iclamp(kc - qc + 15, 0, 30);
                float b = rpbL[dr * 31 + dc]; asm volatile("" : "+v"(b));
                const bool ok = (unsigned)(kc - wsq) < 16u;
                s[kb][r] = ok ? s[kb][r] + b : -__builtin_inff(); }
        }
    }
    float mx = -__builtin_inff();
#pragma unroll
    for (int kb = 0; kb < 16; ++kb) mx = fmaxf(fmaxf(mx, fmaxf(s[kb][0], s[kb][1])), fmaxf(s[kb][2], s[kb][3]));
    mx = fmaxf(mx, __shfl_xor(mx, 16)); mx = fmaxf(mx, __shfl_xor(mx, 32));
    const float mnew = fmaxf(st.m, mx);
    const float alpha = fexp2((st.m - mnew) * LOG2E);
    st.m = mnew; st.lsum *= alpha;
#pragma unroll
    for (int d = 0; d < 4; ++d) st.o[d] = st.o[d] * alpha;
    const float mb = mnew * LOG2E;
    float ps = 0.f;
#pragma unroll
    for (int ks = 0; ks < 8; ++ks) {
        float p[8];
#pragma unroll
        for (int r = 0; r < 4; ++r) { p[r] = fexp2(s[2 * ks][r] * LOG2E - mb); p[4 + r] = fexp2(s[2 * ks + 1][r] * LOG2E - mb); }
        ps += ((p[0] + p[1]) + (p[2] + p[3])) + ((p[4] + p[5]) + (p[6] + p[7]));
        u32x4 pw; pw.x = cvt_pk_bf16(p[0], p[1]); pw.y = cvt_pk_bf16(p[2], p[3]); pw.z = cvt_pk_bf16(p[4], p[5]); pw.w = cvt_pk_bf16(p[6], p[7]);
        const bf16x8 pf = __builtin_bit_cast(bf16x8, pw);
        LAS const unsigned char* v0 = vbase + VROW(2 * ks) * 128; LAS const unsigned char* v1 = vbase + VROW(2 * ks + 1) * 128;
#pragma unroll
        for (int d = 0; d < 4; ++d) { const s16x4 a0 = vtr(v0 + voff[d]), a1 = vtr(v1 + voff[d]);
            bf16x8 af; af[0] = a0[0]; af[1] = a0[1]; af[2] = a0[2]; af[3] = a0[3]; af[4] = a1[0]; af[5] = a1[1]; af[6] = a1[2]; af[7] = a1[3];
            st.o[d] = __builtin_amdgcn_mfma_f32_16x16x32_bf16(af, pf, st.o[d], 0, 0, 0); }
        if (ks & 1) asm volatile("" ::: "memory");
    }
    st.lsum += ps;
#undef KOFF
#undef VROW
}

__device__ __forceinline__ void attn_phase(const Frame& F, int l) {
    unsigned char* ws = F.ws; LAS unsigned char* lds = F.lds;
    const int w = F.wave;
    const bf16_t* Qb = (const bf16_t*)(ws + WS_Q); const bf16_t* Kb = (const bf16_t*)(ws + WS_K); const bf16_t* Vb = (const bf16_t*)(ws + WS_V);
    bf16_t* Ob = (bf16_t*)(ws + WS_ATT);
    constexpr int VCTX_ROW0 = 576, KCTX_OFF = (576 + 256) * 128, RPB_OFF = KCTX_OFF + 32768;
    const int qx = F.bid & 7;
    unsigned* qctr = (unsigned*)(ws + WS_CTL + 98304) + (l * 8 + qx) * 64;
    volatile LAS int* QN = (volatile LAS int*)(lds + LDSCTL_OFF + 256);
    if (FTID(F) == 0) QN[0] = (int)__hip_atomic_fetch_add(qctr, 1u, __ATOMIC_RELAXED, __HIP_MEMORY_SCOPE_AGENT);
    __syncthreads();
    int qe = QN[0];
    while (qe < 128) {
        int nxt_ = 0;
        const int item = qe < 64 ? 64 * qx + qe : 512 + 64 * qx + (qe - 64);
        __syncthreads();
        int tid = FTID(F); asm volatile("" : "+v"(tid));
        if (tid == 0) nxt_ = (int)__hip_atomic_fetch_add(qctr, 1u, __ATOMIC_RELAXED, __HIP_MEMORY_SCOPE_AGENT);
        const int lane = tid & 63, i16 = lane & 15, fq = lane >> 4;
        unsigned voff[4];
        { const int qp = i16 >> 2, p = i16 & 3; const int sw = ((2 * fq + (qp >> 1)) & 3) << 1;
#pragma unroll
          for (int d = 0; d < 4; ++d) voff[d] = (unsigned)((4 * fq + qp) * 128 + ((8 * p) & 15) + ((p >> 1) << 4) + (((2 * d) ^ sw) << 4)); }
        unsigned klds[2];
#pragma unroll
        for (int sx = 0; sx < 2; ++sx) klds[sx] = (unsigned)(KCTX_OFF + i16 * 128 + (((4 * sx + fq) ^ (i16 & 7)) << 4));
        if (item < 512) {
            const int b = item >> 7, h = (item >> 3) & 15, rp = item & 7;
            const int rs2 = iclamp(2 * rp - 4, 0, 8); const int nrows = (rs2 + 9 > 16 ? 16 - rs2 : 9) * 64;
            const int tokb = NPR + b * 1024;
            {
                const int r0 = tid >> 3, ch = tid & 7; u32x4 xl[9], xc[4], xk[4];
                const bf16_t* ksrc = (const bf16_t*)(ws + WS_CK) + (size_t)((b * 2 + l) * 256 + r0) * 1024 + h * 64 + ch * 8;
                const bf16_t* vsrc = Vb + (size_t)(tokb + rs2 * 64 + r0) * 1024 + h * 64 + ch * 8;
                const bf16_t* csrc = (const bf16_t*)(ws + WS_CV) + (size_t)((b * 2 + l) * 256 + r0) * 1024 + h * 64 + ch * 8;
#pragma unroll
                for (int k = 0; k < 9; ++k) xl[k] = *(const u32x4*)(vsrc + (size_t)((64 * k < nrows) ? k : 0) * 64 * 1024);
#pragma unroll
                for (int k = 0; k < 4; ++k) { xc[k] = *(const u32x4*)(csrc + (size_t)k * 64 * 1024); xk[k] = *(const u32x4*)(ksrc + (size_t)k * 64 * 1024); }
#pragma unroll
                for (int k = 0; k < 9; ++k) if (64 * k < nrows) *(LAS u32x4*)(lds + vswz(r0 + 64 * k, ch * 16)) = xl[k];
#pragma unroll
                for (int k = 0; k < 4; ++k) { *(LAS u32x4*)(lds + vswz(VCTX_ROW0 + r0 + 64 * k, ch * 16)) = xc[k]; *(LAS u32x4*)(lds + KCTX_OFF + (r0 + 64 * k) * 128 + ((ch ^ (r0 & 7)) << 4)) = xk[k]; }
            }
            const float* rp_g = FIN(IN_RPB) + (size_t)(l * 16 + h) * 465;
            for (int idx = tid; idx < 465; idx += 512) ((LAS float*)(lds + RPB_OFF))[idx] = rp_g[idx];
            if (tid == 0) QN[0] = nxt_;
            __syncthreads();
            nxt_ = QN[0];
            const int r = 2 * rp + (w >> 2), n = w & 3;
            const int rs = iclamp(r - 4, 0, 8), cs = iclamp(16 * n - 8, 0, 32);
            const int qtok = tokb + r * 64 + 16 * n + i16;
            bf16x8 qf[2]; { const bf16_t* qp = Qb + (size_t)qtok * 1024 + h * 64 + 8 * fq; qf[0] = *(const bf16x8*)qp; qf[1] = *(const bf16x8*)(qp + 32); }
            int qc = 16 * n + i16; asm volatile("" : "+v"(qc));
            const int wsq = iclamp(qc - 8, 0, 48);
            AttnState st; st.m = -__builtin_inff(); st.lsum = 0.f;
#pragma unroll
            for (int d = 0; d < 4; ++d) st.o[d] = (f32x4){0.f, 0.f, 0.f, 0.f};
            const bf16_t* kpl = Kb + (size_t)(tokb + rs * 64 + cs + i16) * 1024 + h * 64 + 8 * fq;
            attn_chunk<true, false>(st, qf, kpl, klds, lds, (rs - rs2) * 64 + cs, voff, (LAS const float*)(lds + RPB_OFF), qc, wsq, cs, rs - r + 7, fq);
            attn_chunk<false, true>(st, qf, nullptr, klds, lds, VCTX_ROW0, voff, nullptr, 0, 0, 0, 0, fq);
            float lt = st.lsum; lt += __shfl_xor(lt, 16); lt += __shfl_xor(lt, 32);
            const float inv = 1.0f / lt;
            bf16_t* op = Ob + (size_t)qtok * 1024 + h * 64 + 4 * fq;
#pragma unroll
            for (int d = 0; d < 4; ++d) { const f32x4 o = st.o[d] * inv; u32x2 wv; wv.x = cvt_pk_bf16(o[0], o[1]); wv.y = cvt_pk_bf16(o[2], o[3]); *(u32x2*)(op + 16 * d) = wv; }
        } else {
            const int x = item - 512, b = x >> 5, h = (x >> 1) & 15, qh = x & 1;
            { const int r0 = tid >> 3, ch = tid & 7; u32x4 xc[4], xk[4]; const bf16_t* vsrc = Vb + (size_t)(b * 256 + r0) * 1024 + h * 64 + ch * 8; const bf16_t* ksrc = Kb + (size_t)(b * 256 + r0) * 1024 + h * 64 + ch * 8;
#pragma unroll
                for (int k = 0; k < 4; ++k) { xc[k] = *(const u32x4*)(vsrc + (size_t)k * 64 * 1024); xk[k] = *(const u32x4*)(ksrc + (size_t)k * 64 * 1024); }
#pragma unroll
                for (int k = 0; k < 4; ++k) { *(LAS u32x4*)(lds + vswz(r0 + 64 * k, ch * 16)) = xc[k]; *(LAS u32x4*)(lds + KCTX_OFF + (r0 + 64 * k) * 128 + ((ch ^ (r0 & 7)) << 4)) = xk[k]; } }
            if (tid == 0) QN[0] = nxt_;
            __syncthreads();
            nxt_ = QN[0];
            const int qtok = b * 256 + qh * 128 + 16 * w + i16;
            bf16x8 qf[2]; { const bf16_t* qp = Qb + (size_t)qtok * 1024 + h * 64 + 8 * fq; qf[0] = *(const bf16x8*)qp; qf[1] = *(const bf16x8*)(qp + 32); }
            AttnState st; st.m = -__builtin_inff(); st.lsum = 0.f;
#pragma unroll
            for (int d = 0; d < 4; ++d) st.o[d] = (f32x4){0.f, 0.f, 0.f, 0.f};
            attn_chunk<false, true>(st, qf, nullptr, klds, lds, 0, voff, nullptr, 0, 0, 0, 0, fq);
            float lt = st.lsum; lt += __shfl_xor(lt, 16); lt += __shfl_xor(lt, 32);
            const float inv = 1.0f / lt;
            bf16_t* op = Ob + (size_t)qtok * 1024 + h * 64 + 4 * fq;
#pragma unroll
            for (int d = 0; d < 4; ++d) { const f32x4 o = st.o[d] * inv; u32x2 wv; wv.x = cvt_pk_bf16(o[0], o[1]); wv.y = cvt_pk_bf16(o[2], o[3]); *(u32x2*)(op + 16 * d) = wv; }
        }
        qe = __builtin_amdgcn_readfirstlane(nxt_);
    }
    __syncthreads();
}

constexpr int N_PHASES = 17;
__global__ void __launch_bounds__(512, 2) mk_fwd(Args args) {
    extern __shared__ __attribute__((aligned(16))) unsigned char lds_raw[];
    Frame F;
    F.lds = (LAS unsigned char*)lds_raw;
    F.wave = __builtin_amdgcn_readfirstlane((int)threadIdx.x >> 6); F.G = gridDim.x; F.bid = blockIdx.x;
    F.out = args.out; F.ws = args.ws;
    volatile LAS unsigned* MISC = (volatile LAS unsigned*)(F.lds + LDSCTL_OFF);
    for (int u = FTID(F); u < 2048 / 4; u += 512) ((LAS unsigned*)(F.lds + LDSCTL_OFF))[u] = 0u;
    __syncthreads();
    const int lo = args.ph_lo, hi = args.ph_hi;
    XcdBarrier bar; bar.bar = (unsigned*)(F.ws + WS_CTL); bar.x = 0; bar.st = nullptr;
    if (hi - lo > 1) bar = xcd_barrier_post((unsigned*)(F.ws + WS_CTL), MISC + 8);
#ifndef MK_REPEAT_PH
#define MK_REPEAT_PH -1
#endif
    for (int pp = lo; pp < hi + (MK_REPEAT_PH >= 0 ? 1 : 0); ++pp) {
        const int ph = (MK_REPEAT_PH >= 0 && pp > MK_REPEAT_PH) ? pp - 1 : pp;
        int g256 = F.G; asm volatile("" : "+s"(g256));
        const bool split = (g256 == 256);
        constexpr int NGEMM1 = 205, NGEMM4 = 235, NLATE = 7000;
        int cv_lo = 0, cv_hi = 0, cv_gw = 0, cv_n = 1;
        if (ph == 0) { p0_phase(F); cv_hi = split ? I_EARLY : 2 * I_LAYER; cv_gw = F.bid * 8 + F.wave; cv_n = F.G * 8; }
        else {
            const int l = (ph - 1) / 8, s = (ph - 1) % 8;
            const bool fusedn = (g256 == 256);
            if (fusedn && (s == 5 || s == 0)) continue;
            if (s == 0) norm_phase(F, l, 0);
            if (s == 5) norm_phase(F, l, 1);
            int gt = -1, geff = F.G;
            if (s == 1) gt = GT_G1; else if (s == 2) gt = GT_DFTPOS; else if (s == 3) gt = GT_G2; else if (s == 4) gt = GT_G3; else if (s == 6) gt = GT_G4; else if (s == 7) gt = GT_G5;
            if (split && ph == 2) { geff = NGEMM1; if (F.bid >= NGEMM1) { gt = -1; cv_lo = I_EARLY; cv_hi = 2 * I_LAYER - NLATE; cv_gw = (F.bid - NGEMM1) * 8 + F.wave; cv_n = (256 - NGEMM1) * 8; } }
            if (split && ph == 7) { geff = NGEMM4; if (F.bid >= NGEMM4) { gt = -1; cv_lo = 2 * I_LAYER - NLATE; cv_hi = 2 * I_LAYER; cv_gw = (F.bid - NGEMM4) * 8 + F.wave; cv_n = (256 - NGEMM4) * 8; } }
#ifndef MK_ATTN_REP
#define MK_ATTN_REP 1
#endif
#ifndef MK_DFT_REP
#define MK_DFT_REP 1
#endif
            int nrep_g = (s == 2) ? MK_DFT_REP : 1, nrep_a = MK_ATTN_REP; asm volatile("" : "+s"(nrep_g), "+s"(nrep_a));
            const bool g4h = split && (ph == 15);
            if (g4h) gt = GT_G4M;
            if (gt >= 0) for (int rep = 0; rep < nrep_g; ++rep) gemm_phase(F, gt, l, geff);
            if (g4h) gemm_half_g4(F, l);
            if (s == 2) for (int rep = 0; rep < nrep_a; ++rep) attn_phase(F, l);
        }
        if (cv_hi > cv_lo) convert_range(F, cv_lo, cv_hi, cv_gw, cv_n);
        if (ph == 0 && split) {
            if (FTID(F) == 0) { unsigned sp = 0; while (__hip_atomic_load((unsigned*)(F.ws + WS_CTL + 110592), __ATOMIC_RELAXED, __HIP_MEMORY_SCOPE_AGENT) < 43u && ++sp < (1u << 22)) __builtin_amdgcn_s_sleep(2);
                __builtin_amdgcn_fence(__ATOMIC_ACQUIRE, "agent"); asm volatile("s_waitcnt vmcnt(0)" ::: "memory"); }
            __syncthreads();
            norm_phase(F, 0, 0);
        }
        if (ph + 1 < hi) xcd_barrier(bar);
    }
}


#if defined(MK_DEBUG_CHECK)
__device__ __forceinline__ float bf2f(bf16_t v) { return __uint_as_float(((unsigned)v) << 16); }
__device__ __forceinline__ float f2bf2f(float f) { unsigned u = __float_as_uint(f); u += 0x7fffu + ((u >> 16) & 1u); return __uint_as_float(u & 0xffff0000u); }
__device__ __forceinline__ unsigned hash32(unsigned x) { x ^= x >> 16; x *= 0x7feb352dU; x ^= x >> 15; x *= 0x846ca68bU; x ^= x >> 16; return x; }
__device__ __forceinline__ void dbg_report(unsigned* slot, float e) { if (!(e >= 0.f)) e = 1e30f; atomicMax(slot, __float_as_uint(e)); }
__global__ void __launch_bounds__(64) dbg_check(Args a, int mode, int l) {
    const unsigned sid = blockIdx.x * blockDim.x + threadIdx.x; const unsigned hs = hash32(sid * 2654435761u + 12345u + mode * 977u);
    unsigned char* ws = a.ws; unsigned* slot = (unsigned*)(ws + WS_CTL + 32768) + mode;
    const float* MOD = (const float*)(ws + WS_MOD);
    if (mode == 0) {
        const int row = hs % NTOK, col = (hs >> 13) % DM; const float* xr = row < NPR ? FIN(IN_XP) + (size_t)row * DM : FIN(IN_XS) + (size_t)(row - NPR) * DM;
        float ss = 0.f; for (int k = 0; k < DM; ++k) ss += xr[k] * xr[k];
        const int cnd = row < NPR ? 4 : ((row - NPR) >> 10); const float* cv = cnd < 4 ? FIN(IN_C) + cnd * DM : FIN(IN_CCTX);
        float sh = FIN(IN_BMOD)[l * NMOD + col], sc = FIN(IN_BMOD)[l * NMOD + DM + col];
        for (int k = 0; k < DM; ++k) { const float v = cv[k], sv = v / (1.f + expf(-v)); sh += sv * FIN(IN_WMOD)[((size_t)l * DM + k) * NMOD + col]; sc += sv * FIN(IN_WMOD)[((size_t)l * DM + k) * NMOD + DM + col]; }
        const float ref = xr[col] * (1.f / sqrtf(ss / DM + EPS)) * FIN(IN_N1)[l * DM + col] * (1.f + sc) + sh;
        const float got = bf2f(((const bf16_t*)(ws + WS_H))[(size_t)row * DM + col]);
        dbg_report(slot, fabsf(got - ref) / (fabsf(ref) + 0.05f));
    } else if (mode == 1 || mode == 3) {
        const int row = hs % NTOK, col = (hs >> 13) % (mode == 1 ? 1024 : 4096); const bf16_t* hr = (const bf16_t*)(ws + WS_H) + (size_t)row * DM;
        const float* W = (mode == 1 ? FIN(IN_WIN) + (size_t)l * DM * 4096 + 2048 : FIN(IN_WGATE) + (size_t)l * DM * 4096) + col;
        float acc = 0.f, sa = 0.f; for (int k = 0; k < DM; ++k) { const float p = bf2f(hr[k]) * f2bf2f(W[(size_t)k * 4096]); acc += p; sa += fabsf(p); }
        float got, ref;
        if (mode == 1) { ref = acc; got = bf2f(((const bf16_t*)(ws + WS_V))[(size_t)row * 1024 + col]); }
        else { ref = 1.f / (1.f + expf(-acc)); h16x2 hh = __builtin_bit_cast(h16x2, (unsigned)((const unsigned short*)(ws + WS_G))[(size_t)row * 4096 + col]); got = (float)hh.x; }
        dbg_report(slot, fabsf(got - ref) / (mode == 1 ? (0.02f * sa + 1e-3f) : 1.0f));
    } else if (mode == 2) {
        const int row = hs % NTOK, head = (hs >> 13) % 16, d0 = (hs >> 17) % 64; const bf16_t* hr = (const bf16_t*)(ws + WS_H) + (size_t)row * DM;
        float ss = 0.f, mine = 0.f;
        for (int d = 0; d < 64; ++d) { const float* W = FIN(IN_WIN) + (size_t)l * DM * 4096 + head * 64 + d; float acc = 0.f; for (int k = 0; k < DM; ++k) acc += bf2f(hr[k]) * f2bf2f(W[(size_t)k * 4096]); ss += acc * acc; if (d == d0) mine = acc; }
        const float ref = mine * (1.f / sqrtf(ss / 64.f + EPS)) * FIN(IN_QG)[l * 64 + d0] * 0.125f;
        const float got = bf2f(((const bf16_t*)(ws + WS_Q))[(size_t)row * 1024 + head * 64 + d0]);
        dbg_report(slot, fabsf(got - ref) / 0.125f);
    } else if (mode == 4 || mode == 5) {
        const bf16_t* Qb = (const bf16_t*)(ws + WS_Q); const bf16_t* Kb = (const bf16_t*)(ws + WS_K); const bf16_t* Vb = (const bf16_t*)(ws + WS_V);
        const int h = (hs >> 13) % 16; int tok;
        if (mode == 4) tok = NPR + hs % 4096; else tok = hs % NPR;
        __shared__ float sq_[64 * 64], so_[64 * 64];
#define q(d) sq_[(d) * 64 + threadIdx.x]
#define o(d) so_[(d) * 64 + threadIdx.x]
        for (int d = 0; d < 64; ++d) q(d) = bf2f(Qb[(size_t)tok * 1024 + h * 64 + d]);
        float mx = -1e30f, lsum = 0.f; for (int d = 0; d < 64; ++d) o(d) = 0.f;
        for (int pass = 0; pass < 2; ++pass) {
            if (mode == 4) {
                const int b = (tok - NPR) >> 10, tt = (tok - NPR) & 1023, r = tt >> 6, qc = tt & 63, rs = iclamp(r - 4, 0, 8), wsq = iclamp(qc - 8, 0, 48);
#if !defined(MK_NATT_VARIANT) || MK_NATT_VARIANT != 1
                for (int i = 0; i < 8; ++i) for (int j = 0; j < 16; ++j) { const int kr = rs + i, kc = wsq + j, kt = NPR + b * 1024 + kr * 64 + kc;
                    float sc = 0.f; for (int d = 0; d < 64; ++d) sc += q(d) * bf2f(Kb[(size_t)kt * 1024 + h * 64 + d]);
                    sc += FIN(IN_RPB)[(size_t)(l * 16 + h) * 465 + (kr - r + 7) * 31 + iclamp(kc - qc + 15, 0, 30)];
                    if (pass == 0) mx = fmaxf(mx, sc); else { const float p = expf(sc - mx); lsum += p; for (int d = 0; d < 64; ++d) o(d) += p * bf2f(Vb[(size_t)kt * 1024 + h * 64 + d]); } }
#endif
#if !defined(MK_NATT_VARIANT) || MK_NATT_VARIANT != 2
                for (int j = 0; j < 256; ++j) { const size_t kt = (size_t)((b * 2 + l) * 256 + j);
                    float sc = 0.f; for (int d = 0; d < 64; ++d) sc += q(d) * FIN(IN_CK)[kt * 1024 + h * 64 + d];
                    if (pass == 0) mx = fmaxf(mx, sc); else { const float p = expf(sc - mx); lsum += p; for (int d = 0; d < 64; ++d) o(d) += p * FIN(IN_CV)[kt * 1024 + h * 64 + d]; } }
#endif
            } else {
                const int b = tok >> 8;
                for (int j = 0; j < 256; ++j) { const int kt = b * 256 + j;
                    float sc = 0.f; for (int d = 0; d < 64; ++d) sc += q(d) * bf2f(Kb[(size_t)kt * 1024 + h * 64 + d]);
                    if (pass == 0) mx = fmaxf(mx, sc); else { const float p = expf(sc - mx); lsum += p; for (int d = 0; d < 64; ++d) o(d) += p * bf2f(Vb[(size_t)kt * 1024 + h * 64 + d]); } }
            }
        }
        float rms = 0.f, err = 0.f; for (int d = 0; d < 64; ++d) { const float ref = o(d) / lsum; rms += ref * ref; err = fmaxf(err, fabsf(bf2f(((const bf16_t*)(ws + WS_ATT))[(size_t)tok * 1024 + h * 64 + d]) - ref)); }
        { const float e_ = err / (sqrtf(rms / 64.f) + 1e-3f); dbg_report(slot, e_);
          unsigned* cnt = (unsigned*)(ws + WS_CTL + 32768) + 16;
          if (e_ > 0.1f) { atomicAdd(cnt + (mode - 4), 1u);
            if (mode == 4) { const int tt = (tok - NPR) & 1023; atomicAdd(cnt + 4 + (tt >> 6), 1u); atomicAdd(cnt + 20 + ((tt & 63) >> 4), 1u); atomicAdd(cnt + 24 + h, 1u); } } }
#undef q
#undef o
    } else if (mode == 6) {
        const int tok = hs % NTOK, ch = (hs >> 13) % 1024, g = ch >> 8, m = ch & 255; int T, t; const bf16_t* ut;
        if (tok < NPR) { T = 256; t = tok & 255; ut = (const bf16_t*)(ws + WS_UTP) + (size_t)(tok >> 8) * 1024 * 1024; }
        else { T = 1024; t = (tok - NPR) & 1023; ut = (const bf16_t*)(ws + WS_UTS) + (size_t)((tok - NPR) >> 10) * 1024 * 1024; }
        float acc = 0.f, sa = 0.f;
        for (int c = 0; c < 256; ++c) { const bf16_t* ur = ut + (size_t)(g * 256 + rho256(c)) * 1024; const int pc = (m * c) & 255;
            for (int tp = 0; tp < T; ++tp) { const int pt = (t * tp) & (T - 1); const float x = 2.0f * ((float)pt / (float)T + (float)pc / 256.0f); const float v = bf2f(ur[tp]) * cospif(x); acc += v; sa += v * v; } }
        const float ref = acc / sqrtf((float)T * 256.f);
        const float got = bf2f(((const bf16_t*)(ws + WS_F))[(size_t)tok * 1024 + ch]);
        dbg_report(slot, fabsf(got - ref) / (sqrtf(sa / ((float)T * 256.f)) + 1e-3f));
    } else if (mode == 7) {
        const int row = hs % NTOK, col = (hs >> 13) % DM;
        const bf16_t* ar = (const bf16_t*)(ws + WS_ATT) + (size_t)row * 1024; const bf16_t* fr_ = (const bf16_t*)(ws + WS_F) + (size_t)row * 1024;
        float na = 0.f, fn = 0.f; for (int k = 0; k < 1024; ++k) { na += bf2f(ar[k]) * f2bf2f(FIN(IN_WNA)[((size_t)l * 1024 + k) * DM + col]); fn += bf2f(fr_[k]) * f2bf2f(FIN(IN_WFN)[((size_t)l * 1024 + k) * DM + col]); }
        const unsigned short* gr = (const unsigned short*)(ws + WS_G) + (size_t)row * 4096;
        h16x2 h1 = __builtin_bit_cast(h16x2, (unsigned)gr[col]), h2 = __builtin_bit_cast(h16x2, (unsigned)gr[2048 + col]);
        const float ref = (float)h1.x * na + (float)h2.x * fn;
        const float got = bf2f(((const bf16_t*)(ws + WS_MIX))[(size_t)row * DM + col]);
        dbg_report(slot, fabsf(got - ref) / (fabsf((float)h1.x * na) + fabsf((float)h2.x * fn) + 0.02f));
    } else if (mode == 8 || mode == 10) {
        const int row = hs % NTOK, col = (hs >> 13) % DM; const int cnd = row < NPR ? 4 : ((row - NPR) >> 10);
        float acc = 0.f, sa = 0.f; float base, gate, got;
        if (mode == 8) { const bf16_t* mr = (const bf16_t*)(ws + WS_MIX) + (size_t)row * DM; for (int k = 0; k < DM; ++k) { const float p = bf2f(mr[k]) * f2bf2f(FIN(IN_WO)[((size_t)l * DM + k) * DM + col]); acc += p; sa += fabsf(p); }
            base = row < NPR ? FIN(IN_XP)[(size_t)row * DM + col] : FIN(IN_XS)[(size_t)(row - NPR) * DM + col]; gate = MOD[(size_t)(l * 5 + cnd) * NMOD + 2 * DM + col]; got = ((const float*)(ws + WS_X1))[(size_t)row * DM + col]; }
        else { const bf16_t* mr = (const bf16_t*)(ws + WS_ACT) + (size_t)row * DFF; for (int k = 0; k < DFF; ++k) { const float p = bf2f(mr[k]) * f2bf2f(FIN(IN_WD)[((size_t)l * DFF + k) * DM + col]); acc += p; sa += fabsf(p); }
            base = ((const float*)(ws + WS_X1))[(size_t)row * DM + col]; gate = MOD[(size_t)(l * 5 + cnd) * NMOD + 5 * DM + col]; got = ((const float*)(ws + WS_X2))[(size_t)row * DM + col]; }
        const float ref = base + gate * acc;
        dbg_report(slot, fabsf(got - ref) / (0.02f * fabsf(gate) * sa + 1e-3f));
    } else if (mode == 9) {
        const int row = hs % NTOK, col = (hs >> 13) % DFF; const bf16_t* hr = (const bf16_t*)(ws + WS_H) + (size_t)row * DM;
        float aa = 0.f, gg = 0.f; for (int k = 0; k < DM; ++k) { const float hv = bf2f(hr[k]); aa += hv * f2bf2f(FIN(IN_WGU)[((size_t)l * DM + k) * 2 * DFF + col]); gg += hv * f2bf2f(FIN(IN_WGU)[((size_t)l * DM + k) * 2 * DFF + DFF + col]); }
        const float ref = aa * gg / (1.f + expf(-gg));
        const float got = bf2f(((const bf16_t*)(ws + WS_ACT))[(size_t)row * DFF + col]);
        dbg_report(slot, fabsf(got - ref) / (fabsf(ref) + 0.05f));
    }
}
__global__ void dbg_emit(Args a, int nmodes, float tol, int out_total) {
    const unsigned* slot = (const unsigned*)(a.ws + WS_CTL + 32768);
    for (int i = blockIdx.x * blockDim.x + threadIdx.x; i < out_total; i += gridDim.x * blockDim.x) a.out[i] = 0.f;
    __syncthreads();
    if (blockIdx.x == 0 && threadIdx.x == 0) {
#if defined(MK_DEBUG_COUNT)
        { unsigned c_ = slot[MK_DEBUG_COUNT] + 1u; int bk = 0; while (c_ > 1u) { c_ >>= 1; ++bk; } float V = 1e3f; for (int i = 0; i < bk; ++i) V *= 10.f; a.out[0] = V; }
#elif defined(MK_DEBUG_VALUE)
        a.out[0] = __uint_as_float(slot[MK_DEBUG_VALUE]) * 1e7f;
#else
        float V = 0.f; float dec = 1e3f;
        for (int m = 0; m < nmodes; ++m) { if (__uint_as_float(slot[m]) > tol && V == 0.f) V = dec; dec *= 10.f; }
        a.out[0] = V;
#endif
    }
}
#endif

extern "C" void kernel_launch(void* const* d_in, const int* in_sizes, int n_in, void* d_out, int out_size, void* d_ws, size_t ws_size, hipStream_t stream) {
    static int grid = 0;
    if (grid == 0) {
        if (n_in != 20 || ws_size < WS_END) { fprintf(stderr, "kernel_launch: unexpected n_in %d / ws_size %zu (need %zu)\n", n_in, ws_size, (size_t)WS_END); grid = -1; return; }
        int dev = 0, cus = 0, per_cu = 0;
        if (hipGetDevice(&dev) != hipSuccess || hipDeviceGetAttribute(&cus, hipDeviceAttributeMultiprocessorCount, dev) != hipSuccess) { grid = -1; return; }
        if (hipFuncSetAttribute((const void*)mk_fwd, hipFuncAttributeMaxDynamicSharedMemorySize, LDS_BYTES) != hipSuccess) { fprintf(stderr, "kernel_launch: hipFuncSetAttribute failed\n"); grid = -1; return; }
        if (hipOccupancyMaxActiveBlocksPerMultiprocessor(&per_cu, (const void*)mk_fwd, 512, LDS_BYTES) != hipSuccess || per_cu < 1) fprintf(stderr, "kernel_launch: occupancy query says %d\n", per_cu);
        (void)hipGetLastError();
        grid = cus;
        if (grid != 256) fprintf(stderr, "kernel_launch: %d CUs\n", grid);
    }
    if (grid < 0) return;
    (void)hipMemsetAsync((char*)d_ws + WS_CTL, 0, CTL_BYTES, stream);
    Args a{};
    for (int i = 0; i < 20; ++i) a.in[i] = (const float*)d_in[i];
    a.out = (float*)d_out; a.ws = (unsigned char*)d_ws;
#ifndef MK_PH_LIMIT
#define MK_PH_LIMIT N_PHASES
#endif
#if MK_LAUNCH_PER_PHASE
    for (int ph = 0; ph < MK_PH_LIMIT; ++ph) { a.ph_lo = ph; a.ph_hi = ph + 1; hipLaunchKernelGGL(mk_fwd, dim3(grid), dim3(512), LDS_BYTES, stream, a);
#if defined(MK_DEBUG_CHECK)
        { const int l = 0;
          if (ph == 1) hipLaunchKernelGGL(dbg_check, dim3(16), dim3(64), 0, stream, a, 0, l);
          if (ph == 2) { hipLaunchKernelGGL(dbg_check, dim3(64), dim3(64), 0, stream, a, 1, l); hipLaunchKernelGGL(dbg_check, dim3(16), dim3(64), 0, stream, a, 2, l); hipLaunchKernelGGL(dbg_check, dim3(64), dim3(64), 0, stream, a, 3, l); }
          if (ph == 3) { hipLaunchKernelGGL(dbg_check, dim3(64), dim3(64), 0, stream, a, 4, l); hipLaunchKernelGGL(dbg_check, dim3(64), dim3(64), 0, stream, a, 5, l); }
          if (ph == 4) hipLaunchKernelGGL(dbg_check, dim3(32), dim3(64), 0, stream, a, 6, l);
          if (ph == 5) hipLaunchKernelGGL(dbg_check, dim3(64), dim3(64), 0, stream, a, 7, l);
          if (ph == 6) hipLaunchKernelGGL(dbg_check, dim3(64), dim3(64), 0, stream, a, 8, l);
          if (ph == 8) hipLaunchKernelGGL(dbg_check, dim3(64), dim3(64), 0, stream, a, 9, l);
          if (ph == 9) hipLaunchKernelGGL(dbg_check, dim3(64), dim3(64), 0, stream, a, 10, l); }
#endif
    }
#if defined(MK_DEBUG_CHECK)
    hipLaunchKernelGGL(dbg_emit, dim3(256), dim3(256), 0, stream, a, 11, MK_DEBUG_TOL, out_size);
#endif
#else
    a.ph_lo = 0; a.ph_hi = N_PHASES;
    hipLaunchKernelGGL(mk_fwd, dim3(grid), dim3(512), LDS_BYTES, stream, a);
#endif
}
```
